# Optimizing an MI355X kernel written in HIP

```python
import math
import jax
import jax.numpy as jnp
from jax import lax
import numpy as np

D_MODEL = 1024
BATCH = 4
SEQ = 4096
DEPTH = 2

GRID_W = 64
CTX_LEN = 256
EPS = 1e-6

DIFF_HEADS = 6
DIFF_DH = 64
DIFF_QK = DIFF_HEADS * 2 * DIFF_DH
DIFF_V = DIFF_HEADS * 2 * DIFF_DH
FOURIER_GROUPS = 4
FOURIER_GC = 64
FOURIER_W = FOURIER_GROUPS * FOURIER_GC
EVEN_IN = 2 * DIFF_QK + DIFF_V + FOURIER_W
EVEN_MIX = DIFF_V + FOURIER_W
Q_BLOCK = 128
ROPE_BASE = 10000.0
ROPE_PAIRS = DIFF_DH // 4

CHUNK = 128
SGU_GROUPS = 8
SGU_GC = 128
SGU_W = SGU_GROUPS * SGU_GC
ODD_IN = 2 * SGU_W

PEER_HEADS = 8
N_KEYS = 128
N_EXPERTS = N_KEYS * N_KEYS
PEER_TOPK = 16
PEER_DQ = 256
PEER_HALF = PEER_DQ // 2
PEER_BLOCK = 128

N_EVEN = (DEPTH + 1) // 2
N_ODD = DEPTH // 2

kernel_name = 'hybrid_diffattn_fourier_sgu_peer_dit'


def rmsnorm(t, g):
    tf = t.astype(jnp.float32)
    tf = tf * lax.rsqrt(jnp.mean(tf * tf, axis=-1, keepdims=True) + EPS)
    return (tf * g.astype(jnp.float32)).astype(t.dtype)


def axial_rope_tables(rows, dtype):
    r = jnp.repeat(jnp.arange(rows, dtype=jnp.float32), GRID_W)
    col = jnp.tile(jnp.arange(GRID_W, dtype=jnp.float32), rows)
    inv = ROPE_BASE ** (-jnp.arange(ROPE_PAIRS, dtype=jnp.float32) / ROPE_PAIRS)
    ar = r[:, None] * inv
    ac = col[:, None] * inv
    ang = jnp.concatenate([ar, ar, ac, ac], axis=-1)
    return (jnp.cos(ang).astype(dtype)[:, None, None, :],
            jnp.sin(ang).astype(dtype)[:, None, None, :])


def rope_axial(t, cos, sin):
    a, b, c, d = jnp.split(t, 4, axis=-1)
    rot = jnp.concatenate([-b, a, -d, c], axis=-1)
    return t * cos + rot * sin


def diff_attend(q, k, v, lam):
    s = jnp.einsum('bqhmd,bkhmd->bhmqk', q, k).astype(jnp.float32) * (DIFF_DH ** -0.5)
    p = jax.nn.softmax(s, axis=-1)
    a = p[:, :, 0] - lam * p[:, :, 1]
    return jnp.einsum('bhqk,bkhe->bqhe', a.astype(v.dtype), v)


def fourier_mix(f):
    B, L, _ = f.shape
    ff = f.astype(jnp.float32).reshape(B, L, FOURIER_GROUPS, FOURIER_GC)
    y = jnp.fft.fft2(ff, axes=(1, 3), norm='ortho').real
    return y.reshape(B, L, FOURIER_W).astype(f.dtype)


def even_mixer(h, hc, w_in, w_out, lam_p, head_g, layer_num, cos, sin, update_ctx):
    B, L, _ = h.shape
    C = hc.shape[1]
    lam_init = 0.8 - 0.6 * math.exp(-0.3 * (layer_num - 1))
    lp = lam_p.astype(jnp.float32)
    lam = jnp.exp(jnp.dot(lp[0], lp[1])) - jnp.exp(jnp.dot(lp[2], lp[3])) + lam_init
    q, k, v, f = jnp.split(h @ w_in, [DIFF_QK, 2 * DIFF_QK, 2 * DIFF_QK + DIFF_V], axis=-1)
    q = rope_axial(q.reshape(B, L, DIFF_HEADS, 2, DIFF_DH), cos, sin)
    k = rope_axial(k.reshape(B, L, DIFF_HEADS, 2, DIFF_DH), cos, sin)
    v = v.reshape(B, L, DIFF_HEADS, 2 * DIFF_DH)
    kc, vc = jnp.split(hc @ w_in[:, DIFF_QK:2 * DIFF_QK + DIFF_V], [DIFF_QK], axis=-1)
    kc = kc.reshape(B, C, DIFF_HEADS, 2, DIFF_DH)
    vc = vc.reshape(B, C, DIFF_HEADS, 2 * DIFF_DH)
    k_all = jnp.concatenate([kc, k], axis=1)
    v_all = jnp.concatenate([vc, v], axis=1)
    nb = L // Q_BLOCK
    qb = jnp.swapaxes(q.reshape(B, nb, Q_BLOCK, DIFF_HEADS, 2, DIFF_DH), 0, 1)
    o = lax.map(lambda qq: diff_attend(qq, k_all, v_all, lam), qb)
    o = jnp.swapaxes(o, 0, 1).reshape(B, L, DIFF_HEADS, 2 * DIFF_DH)
    o = (rmsnorm(o, head_g) * (1.0 - lam_init)).reshape(B, L, DIFF_V)
    y = jnp.concatenate([o, fourier_mix(f)], axis=-1) @ w_out
    if not update_ctx:
        return y, None
    qc = (hc @ w_in[:, :DIFF_QK]).reshape(B, C, DIFF_HEADS, 2, DIFF_DH)
    fc = hc @ w_in[:, 2 * DIFF_QK + DIFF_V:]
    oc = diff_attend(qc, kc, vc, lam)
    oc = (rmsnorm(oc, head_g) * (1.0 - lam_init)).reshape(B, C, DIFF_V)
    yc = jnp.concatenate([oc, fourier_mix(fc)], axis=-1) @ w_out
    return y, yc


def sgu_mixer(h, w_in, b_in, ng, ws, bs, w_out):
    B, L, _ = h.shape
    z = jax.nn.gelu(h @ w_in + b_in)
    u, v = jnp.split(z, 2, axis=-1)
    v = rmsnorm(v, ng).reshape(B, L // CHUNK, CHUNK, SGU_GROUPS, SGU_GC)
    s = jnp.einsum('gpq,bnqgc->bnpgc', ws, v) + bs.T[None, None, :, :, None]
    return (u * s.reshape(B, L, SGU_W)) @ w_out


def peer_mix(h, wq, keys, eu, ev):
    shape = h.shape
    tb = h.reshape(-1, PEER_BLOCK, shape[-1])

    def block(t):
        q = (t @ wq).reshape(PEER_BLOCK, PEER_HEADS, 2, PEER_HALF)
        s = jnp.einsum('thsd,hskd->thsk', q, keys).astype(jnp.float32)
        s1, i1 = lax.top_k(s[:, :, 0], PEER_TOPK)
        s2, i2 = lax.top_k(s[:, :, 1], PEER_TOPK)
        cand = (s1[..., :, None] + s2[..., None, :]).reshape(PEER_BLOCK, PEER_HEADS, PEER_TOPK * PEER_TOPK)
        sc, ci = lax.top_k(cand, PEER_TOPK)
        idx = (jnp.take_along_axis(i1, ci // PEER_TOPK, axis=-1) * N_KEYS
               + jnp.take_along_axis(i2, ci % PEER_TOPK, axis=-1))
        gate = jax.nn.softmax(sc, axis=-1)
        u = jnp.take(eu, idx, axis=0)
        act = jax.nn.gelu(jnp.einsum('td,thkd->thk', t, u).astype(jnp.float32))
        vv = jnp.take(ev, idx, axis=0)
        return jnp.einsum('thk,thkd->td', (gate * act).astype(t.dtype), vv)

    return lax.map(block, tb).reshape(shape)


def setup_inputs(seed: int = 0) -> dict:
    key = jax.random.key(seed)
    ks = jax.random.split(key, 24)
    D = D_MODEL

    def nrm(k, shape, s):
        return jax.random.normal(k, shape, jnp.float32) * s

    return {
        'x': nrm(ks[0], (BATCH, SEQ, D), 1.0),
        'c': nrm(ks[1], (BATCH, D), 1.0),
        'ctx': nrm(ks[2], (BATCH, CTX_LEN, D), 1.0),
        'c_ctx': nrm(ks[3], (D,), 1.0),
        'ada_w': nrm(ks[4], (DEPTH, D, 6 * D), 0.5 * D ** -0.5),
        'ada_b': nrm(ks[5], (DEPTH, 6 * D), 0.02),
        'norm1_g': 1.0 + nrm(ks[6], (DEPTH, D), 0.02),
        'norm2_g': 1.0 + nrm(ks[7], (DEPTH, D), 0.02),
        'final_g': 1.0 + nrm(ks[8], (D,), 0.02),
        'even_w_in': nrm(ks[9], (N_EVEN, D, EVEN_IN), D ** -0.5),
        'even_w_out': nrm(ks[10], (N_EVEN, EVEN_MIX, D), EVEN_MIX ** -0.5),
        'diff_lambda': nrm(ks[11], (N_EVEN, 4, DIFF_DH), 0.1),
        'diff_norm_g': 1.0 + nrm(ks[12], (N_EVEN, 2 * DIFF_DH), 0.02),
        'odd_w_in': nrm(ks[13], (N_ODD, D, ODD_IN), D ** -0.5),
        'odd_b_in': nrm(ks[14], (N_ODD, ODD_IN), 0.02),
        'sgu_norm_g': 1.0 + nrm(ks[15], (N_ODD, SGU_W), 0.02),
        'sgu_w': nrm(ks[16], (N_ODD, SGU_GROUPS, CHUNK, CHUNK), 0.5 * CHUNK ** -0.5),
        'sgu_b': 1.0 + nrm(ks[17], (N_ODD, SGU_GROUPS, CHUNK), 0.02),
        'odd_w_out': nrm(ks[18], (N_ODD, SGU_W, D), SGU_W ** -0.5),
        'peer_wq': nrm(ks[19], (DEPTH, D, PEER_HEADS * PEER_DQ), D ** -0.5),
        'peer_keys': nrm(ks[20], (DEPTH, PEER_HEADS, 2, N_KEYS, PEER_HALF), PEER_HALF ** -0.5),
        'peer_u': nrm(ks[21], (DEPTH, N_EXPERTS, D), D ** -0.5),
        'peer_v': nrm(ks[22], (DEPTH, N_EXPERTS, D), 0.5),
    }


def reference(x, c, ctx, c_ctx, ada_w, ada_b, norm1_g, norm2_g, final_g,
              even_w_in, even_w_out, diff_lambda, diff_norm_g,
              odd_w_in, odd_b_in, sgu_norm_g, sgu_w, sgu_b, odd_w_out,
              peer_wq, peer_keys, peer_u, peer_v):
    L = x.shape[1]
    rows = L // GRID_W
    cos, sin = axial_rope_tables(rows, x.dtype)
    c_s = jax.nn.silu(c)
    cc_s = jax.nn.silu(c_ctx)
    for i in range(DEPTH):
        even = i % 2 == 0
        update_ctx = any(j % 2 == 0 for j in range(i + 1, DEPTH))
        sh1, sc1, g1, sh2, sc2, g2 = jnp.split((c_s @ ada_w[i] + ada_b[i])[:, None, :], 6, axis=-1)
        h = rmsnorm(x, norm1_g[i]) * (1 + sc1) + sh1
        if even or update_ctx:
            csh1, csc1, cg1, csh2, csc2, cg2 = jnp.split(cc_s @ ada_w[i] + ada_b[i], 6)
            hc = rmsnorm(ctx, norm1_g[i]) * (1 + csc1) + csh1
        if even:
            e = i // 2
            y, yc = even_mixer(h, hc, even_w_in[e], even_w_out[e], diff_lambda[e],
                               diff_norm_g[e], i + 1, cos, sin, update_ctx)
        else:
            od = i // 2
            y = sgu_mixer(h, odd_w_in[od], odd_b_in[od], sgu_norm_g[od], sgu_w[od], sgu_b[od], odd_w_out[od])
            yc = (sgu_mixer(hc, odd_w_in[od], odd_b_in[od], sgu_norm_g[od], sgu_w[od], sgu_b[od], odd_w_out[od])
                  if update_ctx else None)
        x = x + g1 * y
        x = x + g2 * peer_mix(rmsnorm(x, norm2_g[i]) * (1 + sc2) + sh2,
                              peer_wq[i], peer_keys[i], peer_u[i], peer_v[i])
        if update_ctx:
            ctx = ctx + cg1 * yc
            ctx = ctx + cg2 * peer_mix(rmsnorm(ctx, norm2_g[i]) * (1 + csc2) + csh2,
                                       peer_wq[i], peer_keys[i], peer_u[i], peer_v[i])
    return rmsnorm(x, final_g)
```

```cpp
#include <hip/hip_runtime.h>
#include <cstdio>
#include <cstdint>

constexpr int D = 1024, NB = 4, L = 4096, NTOK = NB * L, CTX = 256, NCTX = NB * CTX;
constexpr int EVEN_IN = 2560, QK_W = 768, V_W = 768, F_W = 256;
constexpr int PEER_H = 8, NKEYS = 128, TOPK = 16, PEER_QW = 2048;
constexpr int ODD_IN = 2048, SGU_W = 1024;
constexpr float EPS = 1e-6f;
constexpr size_t MiB = 1u << 20;

constexpr size_t WS_MOD = 0;
constexpr size_t WS_LAM = 1 * MiB;
constexpr size_t WS_A = 16 * MiB;
constexpr size_t WS_B = 80 * MiB;
constexpr size_t WS_C = 240 * MiB;
constexpr size_t WS_KVC = 304 * MiB;
constexpr size_t WS_HC = 312 * MiB;
constexpr size_t WS_IDX = 320 * MiB;
constexpr size_t WS_GATE = 328 * MiB;
constexpr size_t WS_FCS = 352 * MiB;
constexpr size_t WS_END = 400 * MiB;

__device__ __forceinline__ float gelu_tanh(float x) {
    const float u = 0.7978845608028654f * (x + 0.044715f * x * x * x);
    return 0.5f * x * (1.0f + tanhf(u));
}
__device__ __forceinline__ float wave_sum(float v) {
#pragma unroll
    for (int o = 1; o < 64; o <<= 1) v += __shfl_xor(v, o);
    return v;
}

__global__ void __launch_bounds__(256) k_mod(const float* c, const float* c_ctx, const float* ada_w, const float* ada_b, float* mod) {
    const int j = blockIdx.x * 256 + threadIdx.x, b = blockIdx.y, l = blockIdx.z;
    const float* v = (b < 4) ? c + b * D : c_ctx;
    const float* w = ada_w + (size_t)l * D * 6 * D;
    float acc = 0.f;
    for (int k = 0; k < D; ++k) { const float s = v[k]; acc += (s / (1.f + __expf(-s))) * w[(size_t)k * 6 * D + j]; }
    mod[((size_t)l * 5 + b) * 6 * D + j] = acc + ada_b[l * 6 * D + j];
}
__global__ void k_lam(const float* lp, float* lam, float lam_init) {
    if (threadIdx.x == 0 && blockIdx.x == 0) {
        float a = 0.f, b = 0.f;
        for (int i = 0; i < 64; ++i) { a += lp[i] * lp[64 + i]; b += lp[128 + i] * lp[192 + i]; }
        lam[0] = expf(a) - expf(b) + lam_init;
    }
}
__global__ void __launch_bounds__(256) k_normmod(const float* x, const float* g, const float* modl, int rows_per_batch, int fixed_b, int off_sh, int off_sc, float* out, int nrows) {
    const int row = blockIdx.x * 4 + (threadIdx.x >> 6), lane = threadIdx.x & 63;
    if (row >= nrows) return;
    const int b = fixed_b >= 0 ? fixed_b : row / rows_per_batch;
    const float* m = modl + (size_t)b * 6 * D;
    const float4* xr = (const float4*)(x + (size_t)row * D);
    float4 v[4]; float s = 0.f;
#pragma unroll
    for (int j = 0; j < 4; ++j) { v[j] = xr[lane + 64 * j]; s += v[j].x * v[j].x + v[j].y * v[j].y + v[j].z * v[j].z + v[j].w * v[j].w; }
    const float r = rsqrtf(wave_sum(s) * (1.f / D) + EPS);
#pragma unroll
    for (int j = 0; j < 4; ++j) {
        const int c0 = (lane + 64 * j) * 4;
        const float4 gg = *(const float4*)(g + c0), sc = *(const float4*)(m + off_sc + c0), sh = *(const float4*)(m + off_sh + c0);
        float4 o;
        o.x = v[j].x * r * gg.x * (1.f + sc.x) + sh.x; o.y = v[j].y * r * gg.y * (1.f + sc.y) + sh.y;
        o.z = v[j].z * r * gg.z * (1.f + sc.z) + sh.z; o.w = v[j].w * r * gg.w * (1.f + sc.w) + sh.w;
        *(float4*)(out + (size_t)row * D + c0) = o;
    }
}
template <int EPI>
__global__ void __launch_bounds__(256) k_gemm(const float* A, int lda, const float* B, int ldb, float* C, int ldc, int K,
                                              const float* bias, const float* res, int ldres, const float* gate, int rows_per_batch) {
    __shared__ float As[16][68];
    __shared__ float Bs[16][68];
    const int t = threadIdx.x, tx = t & 15, ty = t >> 4;
    const int m0 = blockIdx.y * 64, n0 = blockIdx.x * 64;
    float acc[4][4];
#pragma unroll
    for (int i = 0; i < 4; ++i)
#pragma unroll
        for (int j = 0; j < 4; ++j) acc[i][j] = 0.f;
    const int ar = t >> 2, ak = (t & 3) * 4, br = t >> 4, bc = (t & 15) * 4;
    for (int k0 = 0; k0 < K; k0 += 16) {
        const float4 a4 = *(const float4*)(A + (size_t)(m0 + ar) * lda + k0 + ak);
        const float4 b4 = *(const float4*)(B + (size_t)(k0 + br) * ldb + n0 + bc);
        As[ak + 0][ar] = a4.x; As[ak + 1][ar] = a4.y; As[ak + 2][ar] = a4.z; As[ak + 3][ar] = a4.w;
        *(float4*)&Bs[br][bc] = b4;
        __syncthreads();
#pragma unroll
        for (int kk = 0; kk < 16; ++kk) {
            const float4 av = *(const float4*)&As[kk][ty * 4];
            const float4 bv = *(const float4*)&Bs[kk][tx * 4];
            const float a[4] = {av.x, av.y, av.z, av.w}, b[4] = {bv.x, bv.y, bv.z, bv.w};
#pragma unroll
            for (int i = 0; i < 4; ++i)
#pragma unroll
                for (int j = 0; j < 4; ++j) acc[i][j] += a[i] * b[j];
        }
        __syncthreads();
    }
#pragma unroll
    for (int i = 0; i < 4; ++i) {
        const int row = m0 + ty * 4 + i, col = n0 + tx * 4;
        float o[4];
#pragma unroll
        for (int j = 0; j < 4; ++j) {
            float v = acc[i][j];
            if (EPI == 1) v = gelu_tanh(v + bias[col + j]);
            if (EPI == 2) v = res[(size_t)row * ldres + col + j] + gate[(size_t)(row / rows_per_batch) * 6 * D + col + j] * v;
            o[j] = v;
        }
        *(float4*)(C + (size_t)row * ldc + col) = make_float4(o[0], o[1], o[2], o[3]);
    }
}
__global__ void __launch_bounds__(256) k_rope(float* qkvf) {
    const size_t gid = (size_t)blockIdx.x * 256 + threadIdx.x;
    const int j = gid & 15; const int blk = (gid >> 4) % 24; const int tok = gid / (16 * 24);
    const int t = tok % L, r = t / 64, cc = t % 64;
    const float inv = powf(10000.0f, -(float)j / 16.0f);
    const float ar = (float)r * inv, ac = (float)cc * inv;
    float* p = qkvf + (size_t)tok * EVEN_IN + blk * 64;
    const float a = p[j], b = p[16 + j], c = p[32 + j], d = p[48 + j];
    const float cr = cosf(ar), sr = sinf(ar), c2 = cosf(ac), s2 = sinf(ac);
    p[j] = a * cr - b * sr; p[16 + j] = b * cr + a * sr;
    p[32 + j] = c * c2 - d * s2; p[48 + j] = d * c2 + c * s2;
}
__global__ void __launch_bounds__(256) k_attn(const float* qkvf, const float* kvc, const float* lamp, const float* head_g, float* mix) {
    __shared__ float qs[16][128];
    __shared__ float ks[32][129];
    __shared__ float vs[32][128];
    __shared__ float ps[32][33];
    __shared__ float scl[32], mrow[32], lrow[32];
    const int t = threadIdx.x, qt = blockIdx.x, h = blockIdx.y, b = blockIdx.z;
    const int tok0 = b * L + qt * 16;
    for (int i = t; i < 16 * 128; i += 256) qs[i >> 7][i & 127] = qkvf[(size_t)(tok0 + (i >> 7)) * EVEN_IN + h * 128 + (i & 127)];
    if (t < 32) { mrow[t] = -INFINITY; lrow[t] = 0.f; }
    float o[2][8];
#pragma unroll
    for (int m = 0; m < 2; ++m)
#pragma unroll
        for (int e = 0; e < 8; ++e) o[m][e] = 0.f;
    const int oq = t >> 4, og = t & 15;
    __syncthreads();
    for (int j0 = 0; j0 < CTX + L; j0 += 32) {
        for (int i = t; i < 32 * 128; i += 256) {
            const int kk = i >> 7, c = i & 127, j = j0 + kk;
            float kv, vv;
            if (j < CTX) { const float* row = kvc + (size_t)(b * CTX + j) * 1536; kv = row[h * 128 + c]; vv = row[768 + h * 128 + c]; }
            else { const float* row = qkvf + (size_t)(b * L + j - CTX) * EVEN_IN; kv = row[768 + h * 128 + c]; vv = row[1536 + h * 128 + c]; }
            ks[kk][c] = kv; vs[kk][c] = vv;
        }
        __syncthreads();
        {
            const int key = t & 31;
#pragma unroll
            for (int i = 0; i < 4; ++i) {
                const int p = (t >> 5) + 8 * i, q = p >> 1, m = p & 1;
                float s = 0.f;
                for (int d = 0; d < 64; ++d) s += qs[q][m * 64 + d] * ks[key][m * 64 + d];
                ps[p][key] = s * 0.125f;
            }
        }
        __syncthreads();
        if (t < 32) {
            float mx = mrow[t];
            for (int k = 0; k < 32; ++k) mx = fmaxf(mx, ps[t][k]);
            const float sc = expf(mrow[t] - mx);
            float l = lrow[t] * sc;
            for (int k = 0; k < 32; ++k) { const float e = expf(ps[t][k] - mx); ps[t][k] = e; l += e; }
            mrow[t] = mx; lrow[t] = l; scl[t] = sc;
        }
        __syncthreads();
#pragma unroll
        for (int m = 0; m < 2; ++m) {
            const float sc = scl[oq * 2 + m];
#pragma unroll
            for (int e = 0; e < 8; ++e) o[m][e] *= sc;
            for (int k = 0; k < 32; ++k) {
                const float p = ps[oq * 2 + m][k];
#pragma unroll
                for (int e = 0; e < 8; ++e) o[m][e] += p * vs[k][og * 8 + e];
            }
        }
        __syncthreads();
    }
    const float lam = lamp[0];
    const float l0 = lrow[oq * 2], l1 = lrow[oq * 2 + 1];
    float v[8], ss = 0.f;
#pragma unroll
    for (int e = 0; e < 8; ++e) { v[e] = o[0][e] / l0 - lam * (o[1][e] / l1); ss += v[e] * v[e]; }
    ss += __shfl_xor(ss, 1); ss += __shfl_xor(ss, 2); ss += __shfl_xor(ss, 4); ss += __shfl_xor(ss, 8);
    const float r = rsqrtf(ss * (1.f / 128.f) + EPS) * 0.8f;
#pragma unroll
    for (int e = 0; e < 8; ++e) mix[(size_t)(tok0 + oq) * D + h * 128 + og * 8 + e] = v[e] * r * head_g[og * 8 + e];
}
__global__ void __launch_bounds__(256) k_chan_dft(const float* qkvf, float* fcs) {
    __shared__ float f[256];
    __shared__ float ct[64], st[64];
    const int tok = blockIdx.x, t = threadIdx.x;
    f[t] = qkvf[(size_t)tok * EVEN_IN + 2304 + t];
    if (t < 64) { ct[t] = cospif((float)t / 32.f); st[t] = sinpif((float)t / 32.f); }
    __syncthreads();
    const int g = t >> 6, k3 = t & 63;
    float c = 0.f, s = 0.f;
    for (int cc = 0; cc < 64; ++cc) { const int ph = (k3 * cc) & 63; c += f[g * 64 + cc] * ct[ph]; s += f[g * 64 + cc] * st[ph]; }
    fcs[(size_t)tok * 512 + t] = c; fcs[(size_t)tok * 512 + 256 + t] = s;
}
__global__ void __launch_bounds__(256) k_pos_dft(const float* fcs, float* mix) {
    __shared__ float tab[4096];
    __shared__ float Ac[16][68], Asn[16][68], Bc[16][68], Bsn[16][68];
    const int t = threadIdx.x, tx = t & 15, ty = t >> 4;
    const int n0c = blockIdx.x * 64, k10 = blockIdx.y * 64, b = blockIdx.z;
    for (int i = t; i < 4096; i += 256) tab[i] = cospif((float)i / 2048.f);
    float acc[4][4];
#pragma unroll
    for (int i = 0; i < 4; ++i)
#pragma unroll
        for (int j = 0; j < 4; ++j) acc[i][j] = 0.f;
    __syncthreads();
    for (int nn = 0; nn < L; nn += 16) {
#pragma unroll
        for (int i = 0; i < 4; ++i) {
            const int e = t + 256 * i, kk = e & 15, r = e >> 4;
            const int ph = ((k10 + r) * (nn + kk)) & 4095;
            Ac[kk][r] = tab[ph]; Asn[kk][r] = tab[(ph - 1024) & 4095];
        }
        {
            const int br = t >> 4, bc = (t & 15) * 4;
            const float* row = fcs + (size_t)(b * L + nn + br) * 512 + n0c + bc;
            *(float4*)&Bc[br][bc] = *(const float4*)row;
            *(float4*)&Bsn[br][bc] = *(const float4*)(row + 256);
        }
        __syncthreads();
#pragma unroll
        for (int kk = 0; kk < 16; ++kk) {
            const float4 ac = *(const float4*)&Ac[kk][ty * 4], as = *(const float4*)&Asn[kk][ty * 4];
            const float4 bc = *(const float4*)&Bc[kk][tx * 4], bs = *(const float4*)&Bsn[kk][tx * 4];
            const float a1[4] = {ac.x, ac.y, ac.z, ac.w}, a2[4] = {as.x, as.y, as.z, as.w};
            const float b1[4] = {bc.x, bc.y, bc.z, bc.w}, b2[4] = {bs.x, bs.y, bs.z, bs.w};
#pragma unroll
            for (int i = 0; i < 4; ++i)
#pragma unroll
                for (int j = 0; j < 4; ++j) acc[i][j] += a1[i] * b1[j] - a2[i] * b2[j];
        }
        __syncthreads();
    }
#pragma unroll
    for (int i = 0; i < 4; ++i)
#pragma unroll
        for (int j = 0; j < 4; ++j) mix[(size_t)(b * L + k10 + ty * 4 + i) * D + 768 + n0c + tx * 4 + j] = acc[i][j] * (1.f / 512.f);
}
__global__ void __launch_bounds__(256) k_peer_topk(const float* pq, const float* keys  , int* idx_out, float* gate_out) {
    __shared__ float qs[8][256];
    __shared__ float sc[8][2][128];
    __shared__ float tv[8][2][16];
    __shared__ int ti[8][2][16];
    __shared__ float cand[8][256];
    __shared__ float fv[8][16];
    __shared__ int fi[8][16];
    const int t = threadIdx.x, tok0 = blockIdx.x * 8, h = blockIdx.y;
    for (int i = t; i < 8 * 256; i += 256) qs[i >> 8][i & 255] = pq[(size_t)(tok0 + (i >> 8)) * PEER_QW + h * 256 + (i & 255)];
    __syncthreads();
    {
        const int s = t >> 7, key = t & 127;
        const float* kr = keys + (((size_t)h * 2 + s) * 128 + key) * 128;
        float acc[8];
#pragma unroll
        for (int i = 0; i < 8; ++i) acc[i] = 0.f;
        for (int d = 0; d < 128; ++d) { const float kv = kr[d];
#pragma unroll
            for (int i = 0; i < 8; ++i) acc[i] += qs[i][s * 128 + d] * kv; }
#pragma unroll
        for (int i = 0; i < 8; ++i) sc[i][s][key] = acc[i];
    }
    __syncthreads();
    for (int e = t; e < 2048; e += 256) {
        const int i = e & 127, s = (e >> 7) & 1, tt = e >> 8;
        const float v = sc[tt][s][i]; int rank = 0;
        for (int j = 0; j < 128; ++j) { const float w = sc[tt][s][j]; rank += (w > v || (w == v && j < i)) ? 1 : 0; }
        if (rank < 16) { tv[tt][s][rank] = v; ti[tt][s][rank] = i; }
    }
    __syncthreads();
    for (int e = t; e < 2048; e += 256) { const int ci = e & 255, tt = e >> 8; cand[tt][ci] = tv[tt][0][ci >> 4] + tv[tt][1][ci & 15]; }
    __syncthreads();
    for (int e = t; e < 2048; e += 256) {
        const int ci = e & 255, tt = e >> 8;
        const float v = cand[tt][ci]; int rank = 0;
        for (int j = 0; j < 256; ++j) { const float w = cand[tt][j]; rank += (w > v || (w == v && j < ci)) ? 1 : 0; }
        if (rank < 16) { fv[tt][rank] = v; fi[tt][rank] = ci; }
    }
    __syncthreads();
    if (t < 128) {
        const int tt = t >> 4, k = t & 15;
        const float mx = fv[tt][0]; float sum = 0.f;
        for (int j = 0; j < 16; ++j) sum += expf(fv[tt][j] - mx);
        const int ci = fi[tt][k];
        idx_out[(size_t)(tok0 + tt) * 128 + h * 16 + k] = ti[tt][0][ci >> 4] * 128 + ti[tt][1][ci & 15];
        gate_out[(size_t)(tok0 + tt) * 128 + h * 16 + k] = expf(fv[tt][k] - mx) / sum;
    }
}
__global__ void __launch_bounds__(256) k_peer_apply(const float* tn, const int* idx, const float* gate, const float* eu, const float* ev, const float* modl, int off_g2, float* x) {
    const int tok = blockIdx.x * 4 + (threadIdx.x >> 6), lane = threadIdx.x & 63;
    const float4* tr = (const float4*)(tn + (size_t)tok * D);
    float4 tv[4], acc[4];
#pragma unroll
    for (int j = 0; j < 4; ++j) { tv[j] = tr[lane + 64 * j]; acc[j] = make_float4(0.f, 0.f, 0.f, 0.f); }
    for (int e = 0; e < 128; ++e) {
        const int ex = idx[(size_t)tok * 128 + e]; const float g = gate[(size_t)tok * 128 + e];
        const float4* ur = (const float4*)(eu + (size_t)ex * D); const float4* vr = (const float4*)(ev + (size_t)ex * D);
        float s = 0.f;
#pragma unroll
        for (int j = 0; j < 4; ++j) { const float4 u = ur[lane + 64 * j]; s += u.x * tv[j].x + u.y * tv[j].y + u.z * tv[j].z + u.w * tv[j].w; }
        const float w = g * gelu_tanh(wave_sum(s));
#pragma unroll
        for (int j = 0; j < 4; ++j) { const float4 v = vr[lane + 64 * j]; acc[j].x += w * v.x; acc[j].y += w * v.y; acc[j].z += w * v.z; acc[j].w += w * v.w; }
    }
    const float* g2 = modl + (size_t)(tok / L) * 6 * D + off_g2;
#pragma unroll
    for (int j = 0; j < 4; ++j) {
        const int c0 = (lane + 64 * j) * 4; float4* xp = (float4*)(x + (size_t)tok * D + c0); float4 xv = *xp; const float4 gg = *(const float4*)(g2 + c0);
        xv.x += gg.x * acc[j].x; xv.y += gg.y * acc[j].y; xv.z += gg.z * acc[j].z; xv.w += gg.w * acc[j].w; *xp = xv;
    }
}
__global__ void __launch_bounds__(256) k_sgu_norm(float* z, const float* ng) {
    const int row = blockIdx.x * 4 + (threadIdx.x >> 6), lane = threadIdx.x & 63;
    float4* vr = (float4*)(z + (size_t)row * ODD_IN + 1024);
    float4 v[4]; float s = 0.f;
#pragma unroll
    for (int j = 0; j < 4; ++j) { v[j] = vr[lane + 64 * j]; s += v[j].x * v[j].x + v[j].y * v[j].y + v[j].z * v[j].z + v[j].w * v[j].w; }
    const float r = rsqrtf(wave_sum(s) * (1.f / 1024.f) + EPS);
#pragma unroll
    for (int j = 0; j < 4; ++j) { const float4 gg = *(const float4*)(ng + (lane + 64 * j) * 4);
        v[j].x *= r * gg.x; v[j].y *= r * gg.y; v[j].z *= r * gg.z; v[j].w *= r * gg.w; vr[lane + 64 * j] = v[j]; }
}
__global__ void __launch_bounds__(256) k_sgu_gate(const float* z, const float* ws, const float* bs, float* us) {
    __shared__ float Ws[32][129];
    __shared__ float Vs[32][128];
    const int t = threadIdx.x, chunk = blockIdx.x, g = blockIdx.y;
    const int tok0 = chunk * 128;
    const int tp = t >> 4, tc = t & 15;
    float acc[8][8];
#pragma unroll
    for (int i = 0; i < 8; ++i)
#pragma unroll
        for (int j = 0; j < 8; ++j) acc[i][j] = 0.f;
    for (int q0 = 0; q0 < 128; q0 += 32) {
        for (int i = t; i < 32 * 128; i += 256) {
            const int qq = i & 31, p = i >> 5;
            Ws[qq][p] = ws[((size_t)g * 128 + p) * 128 + q0 + qq];
        }
        for (int i = t; i < 32 * 128; i += 256) {
            const int qq = i >> 7, c = i & 127;
            Vs[qq][c] = z[(size_t)(tok0 + q0 + qq) * ODD_IN + 1024 + g * 128 + c];
        }
        __syncthreads();
        for (int qq = 0; qq < 32; ++qq) {
            float a[8], b[8];
#pragma unroll
            for (int i = 0; i < 8; ++i) { a[i] = Ws[qq][tp * 8 + i]; b[i] = Vs[qq][tc * 8 + i]; }
#pragma unroll
            for (int i = 0; i < 8; ++i)
#pragma unroll
                for (int j = 0; j < 8; ++j) acc[i][j] += a[i] * b[j];
        }
        __syncthreads();
    }
#pragma unroll
    for (int i = 0; i < 8; ++i) {
        const int p = tp * 8 + i; const float bb = bs[g * 128 + p];
#pragma unroll
        for (int j = 0; j < 8; ++j) { const int c = g * 128 + tc * 8 + j;
            us[(size_t)(tok0 + p) * D + c] = z[(size_t)(tok0 + p) * ODD_IN + c] * (acc[i][j] + bb); }
    }
}
__global__ void __launch_bounds__(256) k_final_norm(float* x, const float* g) {
    const int row = blockIdx.x * 4 + (threadIdx.x >> 6), lane = threadIdx.x & 63;
    float4* xr = (float4*)(x + (size_t)row * D);
    float4 v[4]; float s = 0.f;
#pragma unroll
    for (int j = 0; j < 4; ++j) { v[j] = xr[lane + 64 * j]; s += v[j].x * v[j].x + v[j].y * v[j].y + v[j].z * v[j].z + v[j].w * v[j].w; }
    const float r = rsqrtf(wave_sum(s) * (1.f / D) + EPS);
#pragma unroll
    for (int j = 0; j < 4; ++j) { const float4 gg = *(const float4*)(g + (lane + 64 * j) * 4);
        v[j].x *= r * gg.x; v[j].y *= r * gg.y; v[j].z *= r * gg.z; v[j].w *= r * gg.w; xr[lane + 64 * j] = v[j]; }
}

extern "C" void kernel_launch(void* const* d_in, const int* in_sizes, int n_in, void* d_out, int out_size, void* d_ws, size_t ws_size, hipStream_t stream) {
    if (n_in != 23 || ws_size < WS_END) { fprintf(stderr, "kernel_launch: unexpected n_in %d or ws_size %zu\n", n_in, ws_size); return; }
    const float* x = (const float*)d_in[0]; const float* c = (const float*)d_in[1]; const float* ctx = (const float*)d_in[2]; const float* c_ctx = (const float*)d_in[3];
    const float* ada_w = (const float*)d_in[4]; const float* ada_b = (const float*)d_in[5]; const float* norm1_g = (const float*)d_in[6]; const float* norm2_g = (const float*)d_in[7];
    const float* final_g = (const float*)d_in[8]; const float* even_w_in = (const float*)d_in[9]; const float* even_w_out = (const float*)d_in[10];
    const float* diff_lambda = (const float*)d_in[11]; const float* diff_norm_g = (const float*)d_in[12]; const float* odd_w_in = (const float*)d_in[13];
    const float* odd_b_in = (const float*)d_in[14]; const float* sgu_norm_g = (const float*)d_in[15]; const float* sgu_w = (const float*)d_in[16]; const float* sgu_b = (const float*)d_in[17];
    const float* odd_w_out = (const float*)d_in[18]; const float* peer_wq = (const float*)d_in[19]; const float* peer_keys = (const float*)d_in[20];
    const float* peer_u = (const float*)d_in[21]; const float* peer_v = (const float*)d_in[22];
    char* ws = (char*)d_ws; float* out = (float*)d_out;
    float* MOD = (float*)(ws + WS_MOD); float* LAM = (float*)(ws + WS_LAM); float* A = (float*)(ws + WS_A); float* B = (float*)(ws + WS_B); float* C = (float*)(ws + WS_C);
    float* KVC = (float*)(ws + WS_KVC); float* HC = (float*)(ws + WS_HC); int* IDX = (int*)(ws + WS_IDX); float* GATE = (float*)(ws + WS_GATE); float* FCS = (float*)(ws + WS_FCS);
    const float* MOD0 = MOD; const float* MOD1 = MOD + 5 * 6 * D;
    k_mod<<<dim3(6 * D / 256, 5, 2), 256, 0, stream>>>(c, c_ctx, ada_w, ada_b, MOD);
    k_lam<<<1, 64, 0, stream>>>(diff_lambda, LAM, 0.2f);
    k_normmod<<<NTOK / 4, 256, 0, stream>>>(x, norm1_g, MOD0, L, -1, 0, D, A, NTOK);
    k_normmod<<<NCTX / 4, 256, 0, stream>>>(ctx, norm1_g, MOD0, CTX, 4, 0, D, HC, NCTX);
    k_gemm<0><<<dim3(EVEN_IN / 64, NTOK / 64), 256, 0, stream>>>(A, D, even_w_in, EVEN_IN, B, EVEN_IN, D, nullptr, nullptr, 0, nullptr, 1);
    k_gemm<0><<<dim3(1536 / 64, NCTX / 64), 256, 0, stream>>>(HC, D, even_w_in + 768, EVEN_IN, KVC, 1536, D, nullptr, nullptr, 0, nullptr, 1);
    k_rope<<<NTOK * 24 * 16 / 256, 256, 0, stream>>>(B);
    k_attn<<<dim3(L / 16, 6, NB), 256, 0, stream>>>(B, KVC, LAM, diff_norm_g, C);
    k_chan_dft<<<NTOK, 256, 0, stream>>>(B, FCS);
    k_pos_dft<<<dim3(4, 64, NB), 256, 0, stream>>>(FCS, C);
    k_gemm<2><<<dim3(D / 64, NTOK / 64), 256, 0, stream>>>(C, D, even_w_out, D, out, D, D, nullptr, x, D, MOD0 + 2 * D, L);
    k_normmod<<<NTOK / 4, 256, 0, stream>>>(out, norm2_g, MOD0, L, -1, 3 * D, 4 * D, A, NTOK);
    k_gemm<0><<<dim3(PEER_QW / 64, NTOK / 64), 256, 0, stream>>>(A, D, peer_wq, PEER_QW, B, PEER_QW, D, nullptr, nullptr, 0, nullptr, 1);
    k_peer_topk<<<dim3(NTOK / 8, 8), 256, 0, stream>>>(B, peer_keys, IDX, GATE);
    k_peer_apply<<<NTOK / 4, 256, 0, stream>>>(A, IDX, GATE, peer_u, peer_v, MOD0, 5 * D, out);
    k_normmod<<<NTOK / 4, 256, 0, stream>>>(out, norm1_g + D, MOD1, L, -1, 0, D, A, NTOK);
    k_gemm<1><<<dim3(ODD_IN / 64, NTOK / 64), 256, 0, stream>>>(A, D, odd_w_in, ODD_IN, B, ODD_IN, D, odd_b_in, nullptr, 0, nullptr, 1);
    k_sgu_norm<<<NTOK / 4, 256, 0, stream>>>(B, sgu_norm_g);
    k_sgu_gate<<<dim3(NTOK / 128, 8), 256, 0, stream>>>(B, sgu_w, sgu_b, C);
    k_gemm<2><<<dim3(D / 64, NTOK / 64), 256, 0, stream>>>(C, D, odd_w_out, D, out, D, D, nullptr, out, D, MOD1 + 2 * D, L);
    k_normmod<<<NTOK / 4, 256, 0, stream>>>(out, norm2_g + D, MOD1, L, -1, 3 * D, 4 * D, A, NTOK);
    k_gemm<0><<<dim3(PEER_QW / 64, NTOK / 64), 256, 0, stream>>>(A, D, peer_wq + (size_t)D * PEER_QW, PEER_QW, B, PEER_QW, D, nullptr, nullptr, 0, nullptr, 1);
    k_peer_topk<<<dim3(NTOK / 8, 8), 256, 0, stream>>>(B, peer_keys + (size_t)8 * 2 * 128 * 128, IDX, GATE);
    k_peer_apply<<<NTOK / 4, 256, 0, stream>>>(A, IDX, GATE, peer_u + (size_t)16384 * D, peer_v + (size_t)16384 * D, MOD1, 5 * D, out);
    k_final_norm<<<NTOK / 4, 256, 0, stream>>>(out, final_g);
}
```

```cpp
#include <hip/hip_runtime.h>
#include <cstdio>
#include <cstdint>

constexpr int D = 1024, NB = 4, L = 4096, NTOK = NB * L, CTX = 256, NCTX = NB * CTX;
constexpr int EVEN_IN = 2560, QK_W = 768, V_W = 768, F_W = 256;
constexpr int PEER_H = 8, NKEYS = 128, TOPK = 16, PEER_QW = 2048;
constexpr int ODD_IN = 2048, SGU_W = 1024;
constexpr float EPS = 1e-6f;
constexpr size_t MiB = 1u << 20;


typedef unsigned short bf16_t;
__device__ __forceinline__ unsigned f2bf(float f) { unsigned u = __builtin_bit_cast(unsigned, f); return (u + 0x7fffu + ((u >> 16) & 1u)) >> 16; }
__device__ __forceinline__ unsigned pk2(float lo, float hi) { return f2bf(lo) | (f2bf(hi) << 16); }
__device__ __forceinline__ float bf2f(unsigned short v) { return __builtin_bit_cast(float, (unsigned)v << 16); }
__device__ __forceinline__ float ldv(const float* p) { return *p; }
__device__ __forceinline__ float ldv(const bf16_t* p) { return bf2f(*p); }
__device__ __forceinline__ void stv(float* p, float v) { *p = v; }
__device__ __forceinline__ void stv(bf16_t* p, float v) { *p = (bf16_t)f2bf(v); }
__device__ __forceinline__ float gelu_tanh(float x) {
    const float u = 0.7978845608028654f * (x + 0.044715f * x * x * x);
    return 0.5f * x * (1.0f + tanhf(u));
}
__device__ __forceinline__ float wave_sum(float v) {
#pragma unroll
    for (int o = 1; o < 64; o <<= 1) v += __shfl_xor(v, o);
    return v;
}

__global__ void __launch_bounds__(256) k_mod(const float* c, const float* c_ctx, const float* ada_w, const float* ada_b, float* mod) {
    const int j = blockIdx.x * 256 + threadIdx.x, b = blockIdx.y, l = blockIdx.z;
    const float* v = (b < 4) ? c + b * D : c_ctx;
    const float* w = ada_w + (size_t)l * D * 6 * D;
    float acc = 0.f;
    for (int k = 0; k < D; ++k) { const float s = v[k]; acc += (s / (1.f + __expf(-s))) * w[(size_t)k * 6 * D + j]; }
    mod[((size_t)l * 5 + b) * 6 * D + j] = acc + ada_b[l * 6 * D + j];
}
__global__ void k_lam(const float* lp, float* lam, float lam_init) {
    if (threadIdx.x == 0 && blockIdx.x == 0) {
        float a = 0.f, b = 0.f;
        for (int i = 0; i < 64; ++i) { a += lp[i] * lp[64 + i]; b += lp[128 + i] * lp[192 + i]; }
        lam[0] = expf(a) - expf(b) + lam_init;
    }
}
__global__ void __launch_bounds__(256) k_normmod(const float* x, const float* g, const float* modl, int rows_per_batch, int fixed_b, int off_sh, int off_sc, bf16_t* out, int nrows) {
    const int row = blockIdx.x * 4 + (threadIdx.x >> 6), lane = threadIdx.x & 63;
    if (row >= nrows) return;
    const int b = fixed_b >= 0 ? fixed_b : row / rows_per_batch;
    const float* m = modl + (size_t)b * 6 * D;
    const float4* xr = (const float4*)(x + (size_t)row * D);
    float4 v[4]; float s = 0.f;
#pragma unroll
    for (int j = 0; j < 4; ++j) { v[j] = xr[lane + 64 * j]; s += v[j].x * v[j].x + v[j].y * v[j].y + v[j].z * v[j].z + v[j].w * v[j].w; }
    const float r = rsqrtf(wave_sum(s) * (1.f / D) + EPS);
#pragma unroll
    for (int j = 0; j < 4; ++j) {
        const int c0 = (lane + 64 * j) * 4;
        const float4 gg = *(const float4*)(g + c0), sc = *(const float4*)(m + off_sc + c0), sh = *(const float4*)(m + off_sh + c0);
        float4 o;
        o.x = v[j].x * r * gg.x * (1.f + sc.x) + sh.x; o.y = v[j].y * r * gg.y * (1.f + sc.y) + sh.y;
        o.z = v[j].z * r * gg.z * (1.f + sc.z) + sh.z; o.w = v[j].w * r * gg.w * (1.f + sc.w) + sh.w;
        uint2 w; w.x = pk2(o.x, o.y); w.y = pk2(o.z, o.w);
        *(uint2*)(out + (size_t)row * D + c0) = w;
    }
}
template <int EPI, typename TC>
__global__ void __launch_bounds__(256) k_gemm(const bf16_t* A, int lda, const float* B, int ldb, TC* C, int ldc, int K,
                                              const float* bias, const float* res, int ldres, const float* gate, int rows_per_batch) {
    __shared__ float As[16][68];
    __shared__ float Bs[16][68];
    const int t = threadIdx.x, tx = t & 15, ty = t >> 4;
    const int m0 = blockIdx.y * 64, n0 = blockIdx.x * 64;
    float acc[4][4];
#pragma unroll
    for (int i = 0; i < 4; ++i)
#pragma unroll
        for (int j = 0; j < 4; ++j) acc[i][j] = 0.f;
    const int ar = t >> 2, ak = (t & 3) * 4, br = t >> 4, bc = (t & 15) * 4;
    for (int k0 = 0; k0 < K; k0 += 16) {
        const uint2 a2 = *(const uint2*)(A + (size_t)(m0 + ar) * lda + k0 + ak);
        float4 a4; a4.x = bf2f((unsigned short)(a2.x & 0xffff)); a4.y = bf2f((unsigned short)(a2.x >> 16)); a4.z = bf2f((unsigned short)(a2.y & 0xffff)); a4.w = bf2f((unsigned short)(a2.y >> 16));
        const float4 b4 = *(const float4*)(B + (size_t)(k0 + br) * ldb + n0 + bc);
        As[ak + 0][ar] = a4.x; As[ak + 1][ar] = a4.y; As[ak + 2][ar] = a4.z; As[ak + 3][ar] = a4.w;
        *(float4*)&Bs[br][bc] = b4;
        __syncthreads();
#pragma unroll
        for (int kk = 0; kk < 16; ++kk) {
            const float4 av = *(const float4*)&As[kk][ty * 4];
            const float4 bv = *(const float4*)&Bs[kk][tx * 4];
            const float a[4] = {av.x, av.y, av.z, av.w}, b[4] = {bv.x, bv.y, bv.z, bv.w};
#pragma unroll
            for (int i = 0; i < 4; ++i)
#pragma unroll
                for (int j = 0; j < 4; ++j) acc[i][j] += a[i] * b[j];
        }
        __syncthreads();
    }
#pragma unroll
    for (int i = 0; i < 4; ++i) {
        const int row = m0 + ty * 4 + i, col = n0 + tx * 4;
        float o[4];
#pragma unroll
        for (int j = 0; j < 4; ++j) {
            float v = acc[i][j];
            if (EPI == 1) v = gelu_tanh(v + bias[col + j]);
            if (EPI == 2) v = res[(size_t)row * ldres + col + j] + gate[(size_t)(row / rows_per_batch) * 6 * D + col + j] * v;
            o[j] = v;
        }
#pragma unroll
        for (int j = 0; j < 4; ++j) stv(C + (size_t)row * ldc + col + j, o[j]);
    }
}
__global__ void __launch_bounds__(256) k_rope(bf16_t* qkvf) {
    const size_t gid = (size_t)blockIdx.x * 256 + threadIdx.x;
    const int j = gid & 15; const int blk = (gid >> 4) % 24; const int tok = gid / (16 * 24);
    const int t = tok % L, r = t / 64, cc = t % 64;
    const float inv = powf(10000.0f, -(float)j / 16.0f);
    const float ar = (float)r * inv, ac = (float)cc * inv;
    bf16_t* p = qkvf + (size_t)tok * EVEN_IN + blk * 64;
    const float a = bf2f(p[j]), b = bf2f(p[16 + j]), c = bf2f(p[32 + j]), d = bf2f(p[48 + j]);
    const float cr = cosf(ar), sr = sinf(ar), c2 = cosf(ac), s2 = sinf(ac);
    stv(p + j, a * cr - b * sr); stv(p + 16 + j, b * cr + a * sr);
    stv(p + 32 + j, c * c2 - d * s2); stv(p + 48 + j, d * c2 + c * s2);
}
__global__ void __launch_bounds__(256) k_attn(const bf16_t* qkvf, const bf16_t* kvc, const float* lamp, const float* head_g, bf16_t* mix) {
    __shared__ float qs[16][128];
    __shared__ float ks[32][129];
    __shared__ float vs[32][128];
    __shared__ float ps[32][33];
    __shared__ float scl[32], mrow[32], lrow[32];
    const int t = threadIdx.x, qt = blockIdx.x, h = blockIdx.y, b = blockIdx.z;
    const int tok0 = b * L + qt * 16;
    for (int i = t; i < 16 * 128; i += 256) qs[i >> 7][i & 127] = bf2f(qkvf[(size_t)(tok0 + (i >> 7)) * EVEN_IN + h * 128 + (i & 127)]);
    if (t < 32) { mrow[t] = -INFINITY; lrow[t] = 0.f; }
    float o[2][8];
#pragma unroll
    for (int m = 0; m < 2; ++m)
#pragma unroll
        for (int e = 0; e < 8; ++e) o[m][e] = 0.f;
    const int oq = t >> 4, og = t & 15;
    __syncthreads();
    for (int j0 = 0; j0 < CTX + L; j0 += 32) {
        for (int i = t; i < 32 * 128; i += 256) {
            const int kk = i >> 7, c = i & 127, j = j0 + kk;
            float kv, vv;
            if (j < CTX) { const bf16_t* row = kvc + (size_t)(b * CTX + j) * 1536; kv = bf2f(row[h * 128 + c]); vv = bf2f(row[768 + h * 128 + c]); }
            else { const bf16_t* row = qkvf + (size_t)(b * L + j - CTX) * EVEN_IN; kv = bf2f(row[768 + h * 128 + c]); vv = bf2f(row[1536 + h * 128 + c]); }
            ks[kk][c] = kv; vs[kk][c] = vv;
        }
        __syncthreads();
        {
            const int key = t & 31;
#pragma unroll
            for (int i = 0; i < 4; ++i) {
                const int p = (t >> 5) + 8 * i, q = p >> 1, m = p & 1;
                float s = 0.f;
                for (int d = 0; d < 64; ++d) s += qs[q][m * 64 + d] * ks[key][m * 64 + d];
                ps[p][key] = s * 0.125f;
            }
        }
        __syncthreads();
        if (t < 32) {
            float mx = mrow[t];
            for (int k = 0; k < 32; ++k) mx = fmaxf(mx, ps[t][k]);
            const float sc = expf(mrow[t] - mx);
            float l = lrow[t] * sc;
            for (int k = 0; k < 32; ++k) { const float e = expf(ps[t][k] - mx); ps[t][k] = e; l += e; }
            mrow[t] = mx; lrow[t] = l; scl[t] = sc;
        }
        __syncthreads();
#pragma unroll
        for (int m = 0; m < 2; ++m) {
            const float sc = scl[oq * 2 + m];
#pragma unroll
            for (int e = 0; e < 8; ++e) o[m][e] *= sc;
            for (int k = 0; k < 32; ++k) {
                const float p = ps[oq * 2 + m][k];
#pragma unroll
                for (int e = 0; e < 8; ++e) o[m][e] += p * vs[k][og * 8 + e];
            }
        }
        __syncthreads();
    }
    const float lam = lamp[0];
    const float l0 = lrow[oq * 2], l1 = lrow[oq * 2 + 1];
    float v[8], ss = 0.f;
#pragma unroll
    for (int e = 0; e < 8; ++e) { v[e] = o[0][e] / l0 - lam * (o[1][e] / l1); ss += v[e] * v[e]; }
    ss += __shfl_xor(ss, 1); ss += __shfl_xor(ss, 2); ss += __shfl_xor(ss, 4); ss += __shfl_xor(ss, 8);
    const float r = rsqrtf(ss * (1.f / 128.f) + EPS) * 0.8f;
#pragma unroll
    for (int e = 0; e < 8; ++e) stv(mix + (size_t)(tok0 + oq) * D + h * 128 + og * 8 + e, v[e] * r * head_g[og * 8 + e]);
}
__global__ void __launch_bounds__(256) k_chan_dft(const bf16_t* qkvf, bf16_t* fcs) {
    __shared__ float f[256];
    __shared__ float ct[64], st[64];
    const int tok = blockIdx.x, t = threadIdx.x;
    f[t] = bf2f(qkvf[(size_t)tok * EVEN_IN + 2304 + t]);
    if (t < 64) { ct[t] = cospif((float)t / 32.f); st[t] = sinpif((float)t / 32.f); }
    __syncthreads();
    const int g = t >> 6, k3 = t & 63;
    float c = 0.f, s = 0.f;
    for (int cc = 0; cc < 64; ++cc) { const int ph = (k3 * cc) & 63; c += f[g * 64 + cc] * ct[ph]; s += f[g * 64 + cc] * st[ph]; }
    stv(fcs + (size_t)tok * 512 + t, c); stv(fcs + (size_t)tok * 512 + 256 + t, s);
}
__global__ void __launch_bounds__(256) k_pos_dft(const bf16_t* fcs, bf16_t* mix) {
    __shared__ float tab[4096];
    __shared__ float Ac[16][68], Asn[16][68], Bc[16][68], Bsn[16][68];
    const int t = threadIdx.x, tx = t & 15, ty = t >> 4;
    const int n0c = blockIdx.x * 64, k10 = blockIdx.y * 64, b = blockIdx.z;
    for (int i = t; i < 4096; i += 256) tab[i] = cospif((float)i / 2048.f);
    float acc[4][4];
#pragma unroll
    for (int i = 0; i < 4; ++i)
#pragma unroll
        for (int j = 0; j < 4; ++j) acc[i][j] = 0.f;
    __syncthreads();
    for (int nn = 0; nn < L; nn += 16) {
#pragma unroll
        for (int i = 0; i < 4; ++i) {
            const int e = t + 256 * i, kk = e & 15, r = e >> 4;
            const int ph = ((k10 + r) * (nn + kk)) & 4095;
            Ac[kk][r] = tab[ph]; Asn[kk][r] = tab[(ph - 1024) & 4095];
        }
        {
            const int br = t >> 4, bc = (t & 15) * 4;
            const bf16_t* row = fcs + (size_t)(b * L + nn + br) * 512 + n0c + bc;
#pragma unroll
            for (int q = 0; q < 4; ++q) { Bc[br][bc + q] = bf2f(row[q]); Bsn[br][bc + q] = bf2f(row[256 + q]); }
        }
        __syncthreads();
#pragma unroll
        for (int kk = 0; kk < 16; ++kk) {
            const float4 ac = *(const float4*)&Ac[kk][ty * 4], as = *(const float4*)&Asn[kk][ty * 4];
            const float4 bc = *(const float4*)&Bc[kk][tx * 4], bs = *(const float4*)&Bsn[kk][tx * 4];
            const float a1[4] = {ac.x, ac.y, ac.z, ac.w}, a2[4] = {as.x, as.y, as.z, as.w};
            const float b1[4] = {bc.x, bc.y, bc.z, bc.w}, b2[4] = {bs.x, bs.y, bs.z, bs.w};
#pragma unroll
            for (int i = 0; i < 4; ++i)
#pragma unroll
                for (int j = 0; j < 4; ++j) acc[i][j] += a1[i] * b1[j] - a2[i] * b2[j];
        }
        __syncthreads();
    }
#pragma unroll
    for (int i = 0; i < 4; ++i)
#pragma unroll
        for (int j = 0; j < 4; ++j) stv(mix + (size_t)(b * L + k10 + ty * 4 + i) * D + 768 + n0c + tx * 4 + j, acc[i][j] * (1.f / 512.f));
}
__global__ void __launch_bounds__(256) k_peer_topk(const bf16_t* pq, const float* keys  , int* idx_out, float* gate_out) {
    __shared__ float qs[8][256];
    __shared__ float sc[8][2][128];
    __shared__ float tv[8][2][16];
    __shared__ int ti[8][2][16];
    __shared__ float cand[8][256];
    __shared__ float fv[8][16];
    __shared__ int fi[8][16];
    const int t = threadIdx.x, tok0 = blockIdx.x * 8, h = blockIdx.y;
    for (int i = t; i < 8 * 256; i += 256) qs[i >> 8][i & 255] = bf2f(pq[(size_t)(tok0 + (i >> 8)) * PEER_QW + h * 256 + (i & 255)]);
    __syncthreads();
    {
        const int s = t >> 7, key = t & 127;
        const float* kr = keys + (((size_t)h * 2 + s) * 128 + key) * 128;
        float acc[8];
#pragma unroll
        for (int i = 0; i < 8; ++i) acc[i] = 0.f;
        for (int d = 0; d < 128; ++d) { const float kv = kr[d];
#pragma unroll
            for (int i = 0; i < 8; ++i) acc[i] += qs[i][s * 128 + d] * kv; }
#pragma unroll
        for (int i = 0; i < 8; ++i) sc[i][s][key] = acc[i];
    }
    __syncthreads();
    for (int e = t; e < 2048; e += 256) {
        const int i = e & 127, s = (e >> 7) & 1, tt = e >> 8;
        const float v = sc[tt][s][i]; int rank = 0;
        for (int j = 0; j < 128; ++j) { const float w = sc[tt][s][j]; rank += (w > v || (w == v && j < i)) ? 1 : 0; }
        if (rank < 16) { tv[tt][s][rank] = v; ti[tt][s][rank] = i; }
    }
    __syncthreads();
    for (int e = t; e < 2048; e += 256) { const int ci = e & 255, tt = e >> 8; cand[tt][ci] = tv[tt][0][ci >> 4] + tv[tt][1][ci & 15]; }
    __syncthreads();
    for (int e = t; e < 2048; e += 256) {
        const int ci = e & 255, tt = e >> 8;
        const float v = cand[tt][ci]; int rank = 0;
        for (int j = 0; j < 256; ++j) { const float w = cand[tt][j]; rank += (w > v || (w == v && j < ci)) ? 1 : 0; }
        if (rank < 16) { fv[tt][rank] = v; fi[tt][rank] = ci; }
    }
    __syncthreads();
    if (t < 128) {
        const int tt = t >> 4, k = t & 15;
        const float mx = fv[tt][0]; float sum = 0.f;
        for (int j = 0; j < 16; ++j) sum += expf(fv[tt][j] - mx);
        const int ci = fi[tt][k];
        idx_out[(size_t)(tok0 + tt) * 128 + h * 16 + k] = ti[tt][0][ci >> 4] * 128 + ti[tt][1][ci & 15];
        gate_out[(size_t)(tok0 + tt) * 128 + h * 16 + k] = expf(fv[tt][k] - mx) / sum;
    }
}
__global__ void __launch_bounds__(256) k_peer_apply(const bf16_t* tn, const int* idx, const float* gate, const float* eu, const float* ev, const float* modl, int off_g2, float* x) {
    const int tok = blockIdx.x * 4 + (threadIdx.x >> 6), lane = threadIdx.x & 63;
    const uint2* tr = (const uint2*)(tn + (size_t)tok * D);
    float4 tv[4], acc[4];
#pragma unroll
    for (int j = 0; j < 4; ++j) { const uint2 w = tr[lane + 64 * j];
        tv[j].x = bf2f((unsigned short)(w.x & 0xffff)); tv[j].y = bf2f((unsigned short)(w.x >> 16)); tv[j].z = bf2f((unsigned short)(w.y & 0xffff)); tv[j].w = bf2f((unsigned short)(w.y >> 16));
        acc[j] = make_float4(0.f, 0.f, 0.f, 0.f); }
    for (int e = 0; e < 128; ++e) {
        const int ex = idx[(size_t)tok * 128 + e]; const float g = gate[(size_t)tok * 128 + e];
        const float4* ur = (const float4*)(eu + (size_t)ex * D); const float4* vr = (const float4*)(ev + (size_t)ex * D);
        float s = 0.f;
#pragma unroll
        for (int j = 0; j < 4; ++j) { const float4 u = ur[lane + 64 * j]; s += u.x * tv[j].x + u.y * tv[j].y + u.z * tv[j].z + u.w * tv[j].w; }
        const float w = g * gelu_tanh(wave_sum(s));
#pragma unroll
        for (int j = 0; j < 4; ++j) { const float4 v = vr[lane + 64 * j]; acc[j].x += w * v.x; acc[j].y += w * v.y; acc[j].z += w * v.z; acc[j].w += w * v.w; }
    }
    const float* g2 = modl + (size_t)(tok / L) * 6 * D + off_g2;
#pragma unroll
    for (int j = 0; j < 4; ++j) {
        const int c0 = (lane + 64 * j) * 4; float4* xp = (float4*)(x + (size_t)tok * D + c0); float4 xv = *xp; const float4 gg = *(const float4*)(g2 + c0);
        xv.x += gg.x * acc[j].x; xv.y += gg.y * acc[j].y; xv.z += gg.z * acc[j].z; xv.w += gg.w * acc[j].w; *xp = xv;
    }
}
__global__ void __launch_bounds__(256) k_sgu_norm(bf16_t* z, const float* ng) {
    const int row = blockIdx.x * 4 + (threadIdx.x >> 6), lane = threadIdx.x & 63;
    uint2* vr = (uint2*)(z + (size_t)row * ODD_IN + 1024);
    float4 v[4]; float s = 0.f;
#pragma unroll
    for (int j = 0; j < 4; ++j) { const uint2 w = vr[lane + 64 * j];
        v[j].x = bf2f((unsigned short)(w.x & 0xffff)); v[j].y = bf2f((unsigned short)(w.x >> 16)); v[j].z = bf2f((unsigned short)(w.y & 0xffff)); v[j].w = bf2f((unsigned short)(w.y >> 16)); s += v[j].x * v[j].x + v[j].y * v[j].y + v[j].z * v[j].z + v[j].w * v[j].w; }
    const float r = rsqrtf(wave_sum(s) * (1.f / 1024.f) + EPS);
#pragma unroll
    for (int j = 0; j < 4; ++j) { const float4 gg = *(const float4*)(ng + (lane + 64 * j) * 4);
        v[j].x *= r * gg.x; v[j].y *= r * gg.y; v[j].z *= r * gg.z; v[j].w *= r * gg.w; uint2 w; w.x = pk2(v[j].x, v[j].y); w.y = pk2(v[j].z, v[j].w); vr[lane + 64 * j] = w; }
}
__global__ void __launch_bounds__(256) k_sgu_gate(const bf16_t* z, const float* ws, const float* bs, bf16_t* us) {
    __shared__ float Ws[32][129];
    __shared__ float Vs[32][128];
    const int t = threadIdx.x, chunk = blockIdx.x, g = blockIdx.y;
    const int tok0 = chunk * 128;
    const int tp = t >> 4, tc = t & 15;
    float acc[8][8];
#pragma unroll
    for (int i = 0; i < 8; ++i)
#pragma unroll
        for (int j = 0; j < 8; ++j) acc[i][j] = 0.f;
    for (int q0 = 0; q0 < 128; q0 += 32) {
        for (int i = t; i < 32 * 128; i += 256) {
            const int qq = i & 31, p = i >> 5;
            Ws[qq][p] = ws[((size_t)g * 128 + p) * 128 + q0 + qq];
        }
        for (int i = t; i < 32 * 128; i += 256) {
            const int qq = i >> 7, c = i & 127;
            Vs[qq][c] = bf2f(z[(size_t)(tok0 + q0 + qq) * ODD_IN + 1024 + g * 128 + c]);
        }
        __syncthreads();
        for (int qq = 0; qq < 32; ++qq) {
            float a[8], b[8];
#pragma unroll
            for (int i = 0; i < 8; ++i) { a[i] = Ws[qq][tp * 8 + i]; b[i] = Vs[qq][tc * 8 + i]; }
#pragma unroll
            for (int i = 0; i < 8; ++i)
#pragma unroll
                for (int j = 0; j < 8; ++j) acc[i][j] += a[i] * b[j];
        }
        __syncthreads();
    }
#pragma unroll
    for (int i = 0; i < 8; ++i) {
        const int p = tp * 8 + i; const float bb = bs[g * 128 + p];
#pragma unroll
        for (int j = 0; j < 8; ++j) { const int c = g * 128 + tc * 8 + j;
            stv(us + (size_t)(tok0 + p) * D + c, bf2f(z[(size_t)(tok0 + p) * ODD_IN + c]) * (acc[i][j] + bb)); }
    }
}
__global__ void __launch_bounds__(256) k_final_norm(float* x, const float* g) {
    const int row = blockIdx.x * 4 + (threadIdx.x >> 6), lane = threadIdx.x & 63;
    float4* xr = (float4*)(x + (size_t)row * D);
    float4 v[4]; float s = 0.f;
#pragma unroll
    for (int j = 0; j < 4; ++j) { v[j] = xr[lane + 64 * j]; s += v[j].x * v[j].x + v[j].y * v[j].y + v[j].z * v[j].z + v[j].w * v[j].w; }
    const float r = rsqrtf(wave_sum(s) * (1.f / D) + EPS);
#pragma unroll
    for (int j = 0; j < 4; ++j) { const float4 gg = *(const float4*)(g + (lane + 64 * j) * 4);
        v[j].x *= r * gg.x; v[j].y *= r * gg.y; v[j].z *= r * gg.z; v[j].w *= r * gg.w; xr[lane + 64 * j] = v[j]; }
}

#define LAS __attribute__((address_space(3)))
#define GAS __attribute__((address_space(1)))
typedef short bf16x8 __attribute__((ext_vector_type(8)));
typedef float f32x4 __attribute__((ext_vector_type(4)));
typedef float f32x2 __attribute__((ext_vector_type(2)));
typedef unsigned u32x4 __attribute__((ext_vector_type(4)));
typedef unsigned u32x2 __attribute__((ext_vector_type(2)));
constexpr int NWAVES = 8;
constexpr float C2 = 0.125f * 1.4426950408889634f;

constexpr size_t FW_CTL = 0, CTL_ZERO_BYTES = 1 * MiB;
constexpr size_t FW_MOD = 1 * MiB;
constexpr size_t FW_LAM = 1 * MiB + 512 * 1024;
constexpr size_t FW_ROPE = FW_LAM + 4096;
constexpr size_t FW_TW = 1 * MiB + 768 * 1024;
constexpr size_t FW_MA = FW_TW + 32768;
constexpr size_t FW_MB = FW_MA + 32768;
constexpr size_t FW_WIN = 2 * MiB;
constexpr size_t FW_WOUT = 8 * MiB;
constexpr size_t FW_WQ = 10 * MiB;
constexpr size_t FW_OWIN = 18 * MiB;
constexpr size_t FW_OWOUT = 22 * MiB;
constexpr size_t FW_KEYS = 24 * MiB;
constexpr size_t FW_SGUW = 25 * MiB;
constexpr size_t FW_HC = 26 * MiB;
constexpr size_t FW_H = 32 * MiB;
constexpr size_t FW_QB = 64 * MiB;
constexpr size_t FW_KB = 88 * MiB;
constexpr size_t FW_VT = 114 * MiB;
constexpr size_t FW_FTP = 140 * MiB;
constexpr size_t FW_MIX = 156 * MiB;
constexpr size_t FW_PQ = 64 * MiB;
constexpr size_t FW_ZU = 64 * MiB;
constexpr size_t FW_ZVT = 96 * MiB;
constexpr size_t FW_IDX = 188 * MiB;
constexpr size_t FW_GATE = 196 * MiB;
constexpr size_t FW_TAB = 208 * MiB;
constexpr size_t FW_END = 336 * MiB;
constexpr size_t NW_B = 336 * MiB;
constexpr size_t NW_KVC = 416 * MiB;
constexpr size_t NW_FCS = 420 * MiB;
constexpr size_t WS_NEED = 440 * MiB;
constexpr int KVLEN = CTX + L;
constexpr int CW_KM2 = 64;
constexpr int CW_BAR = 4096;
constexpr int CW_RSQ = 32768;

constexpr int PH_BYTES = 139264, AUX_OFF = PH_BYTES, MISC_OFF = AUX_OFF + 8192, LDS_BYTES = MISC_OFF + 512;

#define LDS_WAIT() asm volatile("s_waitcnt lgkmcnt(0)" ::: "memory")
#define VM_WAIT() asm volatile("s_waitcnt vmcnt(0)" ::: "memory")

#define XB_TMO      128
#define XB_XCNT(j)  (256  + 64 * (j))
#define XB_XSUB(j)  (1280 + 64 * (j))
#define XB_XGEN(j)  (2304 + 64 * (j))
#define XB_TOP      3328
#define XB_TOPGEN   3392
#define XCD_BAR_WORDS 3456
#define XB_SPIN_CAP (1u << 18)
__device__ __forceinline__ unsigned xb_ld(unsigned* p)              { return __hip_atomic_load(p, __ATOMIC_RELAXED, __HIP_MEMORY_SCOPE_AGENT); }
__device__ __forceinline__ unsigned xb_add(unsigned* p, unsigned v) { return __hip_atomic_fetch_add(p, v, __ATOMIC_RELAXED, __HIP_MEMORY_SCOPE_AGENT); }
__device__ __forceinline__ unsigned xb_xcc_id() { return (unsigned)__builtin_amdgcn_s_getreg((3 << 11) | 20) & 0xFu; }
#define XB_SPIN(cond, bar) do { unsigned _sp = 0; while (cond) { __builtin_amdgcn_s_sleep(1); \
    if ((++_sp & 255u) == 0u) { if (xb_ld(&(bar)[XB_TMO])) break; if (_sp > XB_SPIN_CAP) { atomicAdd(&(bar)[XB_TMO], 1u); break; } } } } while (0)
struct XcdBarrier { unsigned* bar; unsigned x; volatile LAS unsigned* st; };
__device__ __forceinline__ XcdBarrier xcd_barrier_post(unsigned* bar, volatile LAS unsigned* st) {
    XcdBarrier b; b.bar = bar; b.x = xb_xcc_id(); b.st = st;
    if (threadIdx.x == 0) (void)xb_add(&bar[XB_XCNT(b.x)], 1u);
    return b;
}
__device__ __forceinline__ void xcd_barrier_complete(unsigned* bar, unsigned x, unsigned& nloc, unsigned& nx) {
    const unsigned G = gridDim.x * gridDim.y * gridDim.z;
    unsigned sum, cnt, mine, sp = 0u;
    for (;;) {
        sum = 0u; cnt = 0u; mine = 0u;
#pragma unroll
        for (unsigned j = 0; j < 16; ++j) { const unsigned c = xb_ld(&bar[XB_XCNT(j)]); sum += c; cnt += (c > 0u) ? 1u : 0u; mine = (j == x) ? c : mine; }
        if (sum == G) break;
        __builtin_amdgcn_s_sleep(1);
        if ((++sp & 255u) == 0u) { if (xb_ld(&bar[XB_TMO])) break; if (sp > XB_SPIN_CAP) { atomicAdd(&bar[XB_TMO], 1u); break; } }
    }
    nloc = mine > 0u ? mine : 1u; nx = cnt > 0u ? cnt : 1u;
}
__device__ __forceinline__ void xcd_barrier(const XcdBarrier& b) {
    asm volatile("s_waitcnt vmcnt(0)" ::: "memory");
    __syncthreads();
    if (threadIdx.x == 0) {
        unsigned* bar = b.bar;
        __builtin_amdgcn_s_waitcnt(0);
        unsigned nloc = b.st[0], nx = b.st[1];
        if (nloc == 0u) { xcd_barrier_complete(bar, b.x, nloc, nx); b.st[0] = nloc; b.st[1] = nx; }
        const unsigned old = xb_add(&bar[XB_XSUB(b.x)], 1u);
        const unsigned gen = old / nloc;
        if (old + 1u == (gen + 1u) * nloc) {
            __builtin_amdgcn_fence(__ATOMIC_RELEASE, "agent");
            asm volatile("s_waitcnt vmcnt(0)" ::: "memory");
            const unsigned og = xb_add(&bar[XB_TOP], 1u);
            const unsigned tg = og / nx;
            if (og + 1u == (tg + 1u) * nx) xb_add(&bar[XB_TOPGEN], 1u);
            else XB_SPIN(xb_ld(&bar[XB_TOPGEN]) == tg, bar);
            __builtin_amdgcn_fence(__ATOMIC_ACQUIRE, "agent");
            xb_add(&bar[XB_XGEN(b.x)], 1u);
            asm volatile("s_waitcnt vmcnt(0)" ::: "memory");
        } else {
            XB_SPIN(xb_ld(&bar[XB_XGEN(b.x)]) == gen, bar);
            __builtin_amdgcn_fence(__ATOMIC_ACQUIRE, "agent");
            asm volatile("s_waitcnt vmcnt(0)" ::: "memory");
        }
    }
    __syncthreads();
}

__device__ __forceinline__ const char* uni_ptr(const char* p) {
    const unsigned long long v = (unsigned long long)p;
    const unsigned lo = __builtin_amdgcn_readfirstlane((unsigned)v), hi = __builtin_amdgcn_readfirstlane((unsigned)(v >> 32));
    return (const char*)(((unsigned long long)hi << 32) | lo);
}
namespace pg8 {
constexpr int BM = 256, BK = 64, HALF = 128, HTB = HALF * BK * 2, STAGE_BYTES = 8 * HTB;
__host__ __device__ __forceinline__ int lds_byte(int r, int c) { const int st = (r >> 4) * 2 + (c >> 5), rr = r & 15, cc = c & 31, ob = rr * 64 + cc * 2; return st * 1024 + (ob ^ (((ob >> 9) & 1) << 5)); }
__host__ __device__ __forceinline__ void stage_rc(int b, int& R, int& C) { const int st = b / 1024, sb = b % 1024, swz = sb ^ (((sb >> 9) & 1) << 5); R = (st >> 1) * 16 + swz / 64; C = (st & 1) * 32 + (swz % 64) / 2; }
struct Unit { const char* A; const char* B; int pm, pn, kind, bperm; };

template <class Epi, class Sched>
__device__ __forceinline__ void gemm_phase(LAS unsigned char* lds, const int K, const Sched& S, const Epi& E) {
    const int tid = threadIdx.x, wid = __builtin_amdgcn_readfirstlane(tid >> 6), lane = tid & 63, wr = wid >> 2, wc = wid & 3, fr = lane & 15, fq = lane >> 4;
    const int nt = K / BK;
    unsigned voffA[2];
#pragma unroll
    for (int i = 0; i < 2; ++i) { int R, C; stage_rc(tid * 16 + i * 8192, R, C); voffA[i] = (unsigned)(R * K + C) * 2u; }
    const size_t kstep = (size_t)(BK * 2);
    const size_t hstepA = (size_t)HALF * K * 2;
    const unsigned ldsw = (unsigned)wid * 1024u;
    const int aoff = lds_byte(wr * 64 + fr, fq * 8), boff = lds_byte(wc * 32 + fr, fq * 8);
#define PG8_SA(b, h) (((b) * 2 + (h)) * HTB)
#define PG8_SB(b, h) ((4 + (b) * 2 + (h)) * HTB)
#define PG8_STAGE2(bufoff, gbase, v0, v1) do { const char* gb_ = uni_ptr((const char*)(gbase)); \
        __builtin_amdgcn_global_load_lds((const unsigned*)(gb_ + (v0)), (LAS unsigned*)(lds + (bufoff) + ldsw), 16, 0, 0); \
        __builtin_amdgcn_global_load_lds((const unsigned*)(gb_ + (v1)), (LAS unsigned*)(lds + (bufoff) + ldsw + 8192), 16, 0, 0); } while (0)
#define PG8_STAGEA(bufoff, gbase) PG8_STAGE2(bufoff, gbase, voffA[0], voffA[1])
#define PG8_STAGEB(bufoff, gbase, pf) do { if (pf) { unsigned vp_[2]; _Pragma("unroll") for (int i_ = 0; i_ < 2; ++i_) { int R_, C_; stage_rc(tid * 16 + i_ * 8192, R_, C_); vp_[i_] = (unsigned)((64 * (R_ & 63) + (R_ >> 6)) * K + C_) * 2u; } \
        PG8_STAGE2(bufoff, gbase, vp_[0], vp_[1]); } else PG8_STAGE2(bufoff, gbase, voffA[0], voffA[1]); } while (0)
#define PG8_LDA(dst, b, h) do { _Pragma("unroll") for (int m = 0; m < 4; ++m) _Pragma("unroll") for (int k = 0; k < 2; ++k) dst[m][k] = *(const LAS bf16x8*)(lds + PG8_SA(b, h) + aoff + m * 2048 + k * 1024); } while (0)
#define PG8_LDB(dst, b, h) do { _Pragma("unroll") for (int n = 0; n < 2; ++n) _Pragma("unroll") for (int k = 0; k < 2; ++k) dst[n][k] = *(const LAS bf16x8*)(lds + PG8_SB(b, h) + boff + n * 2048 + k * 1024); } while (0)
#define PG8_MMA(ai, bj, At, Bt) do { __builtin_amdgcn_s_setprio(1); _Pragma("unroll") for (int m = 0; m < 4; ++m) _Pragma("unroll") for (int n = 0; n < 2; ++n) _Pragma("unroll") for (int k = 0; k < 2; ++k) \
        acc[ai][bj][m][n] = __builtin_amdgcn_mfma_f32_16x16x32_bf16(Bt[n][k], At[m][k], acc[ai][bj][m][n], 0, 0, 0); __builtin_amdgcn_s_setprio(0); } while (0)
#define PG8_WAIT_V(n) asm volatile("s_waitcnt vmcnt(" #n ")" ::: "memory")
#define PG8_WAIT_L(n) asm volatile("s_waitcnt lgkmcnt(" #n ")" ::: "memory")
#define PG8_BAR __builtin_amdgcn_s_barrier()
#define PG8_SCHED __builtin_amdgcn_sched_barrier(0)
    Unit cur, nxt; int ui = 0;
    if (!S.next(0, cur)) return;
    f32x4 acc[2][2][4][2];
#pragma unroll
    for (int a = 0; a < 2; ++a)
#pragma unroll
        for (int b = 0; b < 2; ++b)
#pragma unroll
            for (int m = 0; m < 4; ++m)
#pragma unroll
                for (int n = 0; n < 2; ++n) acc[a][b][m][n] = (f32x4){0.f, 0.f, 0.f, 0.f};
    bf16x8 At[4][2], B0[2][2], B1[2][2];
    const char* cA = cur.A; const char* cB = cur.B;
    bool cpf = cur.bperm != 0;
    unsigned chB = cpf ? (unsigned)(2 * K * 2) : (unsigned)hstepA;
    {
        PG8_STAGEB(PG8_SB(0, 0), cB, cpf); PG8_STAGEB(PG8_SB(0, 1), cB + chB, cpf); PG8_STAGEA(PG8_SA(0, 0), cA); PG8_STAGEA(PG8_SA(0, 1), cA + hstepA);
        if (wr == 1) PG8_BAR;
        PG8_WAIT_V(2); PG8_BAR;
        PG8_STAGEB(PG8_SB(1, 0), cB + kstep, cpf); PG8_STAGEA(PG8_SA(1, 0), cA + kstep); PG8_STAGEB(PG8_SB(1, 1), cB + chB + kstep, cpf);
        PG8_WAIT_V(6); PG8_BAR;
    }
    for (;;) {
        const bool has_next = S.next(ui + 1, nxt);
        const char* nA = has_next ? nxt.A : cA; const char* nB = has_next ? nxt.B : cB;
        const bool npf = has_next ? (nxt.bperm != 0) : cpf;
        const unsigned nhB = npf ? (unsigned)(2 * K * 2) : (unsigned)hstepA;
        for (int t = 0; t < nt; t += 2) {
            const bool last = (t == nt - 2);
            const char* a1 = cA + (size_t)(t + 1) * kstep;
            const char* a2 = last ? nA : cA + (size_t)(t + 2) * kstep; const char* b2 = last ? nB : cB + (size_t)(t + 2) * kstep;
            const char* a3 = a2 + kstep; const char* b3 = b2 + kstep;
            const bool pf2 = last ? npf : cpf; const unsigned h2 = last ? nhB : chB;
            PG8_LDB(B0, 0, 0); PG8_LDB(B1, 0, 1); PG8_SCHED; PG8_LDA(At, 0, 0); PG8_STAGEA(PG8_SA(1, 1), a1 + hstepA);
            PG8_WAIT_V(8); PG8_WAIT_L(0); PG8_BAR; PG8_MMA(0, 0, At, B0); PG8_MMA(0, 1, At, B1); PG8_BAR; PG8_SCHED;
            PG8_LDA(At, 0, 1); PG8_STAGEB(PG8_SB(0, 0), b2, pf2); PG8_STAGEB(PG8_SB(0, 1), b2 + h2, pf2); PG8_STAGEA(PG8_SA(0, 0), a2);
            PG8_WAIT_V(8); PG8_WAIT_L(0); PG8_BAR; PG8_MMA(1, 0, At, B0); PG8_MMA(1, 1, At, B1); PG8_BAR; PG8_SCHED;
            PG8_LDB(B0, 1, 0); PG8_LDB(B1, 1, 1); PG8_SCHED; PG8_LDA(At, 1, 0); PG8_STAGEA(PG8_SA(0, 1), a2 + hstepA);
            PG8_WAIT_V(8); PG8_WAIT_L(0); PG8_BAR; PG8_MMA(0, 0, At, B0); PG8_MMA(0, 1, At, B1); PG8_BAR; PG8_SCHED;
            PG8_LDA(At, 1, 1); PG8_STAGEB(PG8_SB(1, 0), b3, pf2); PG8_STAGEB(PG8_SB(1, 1), b3 + h2, pf2); PG8_STAGEA(PG8_SA(1, 0), a3);
            PG8_WAIT_V(8); PG8_WAIT_L(0); PG8_BAR; PG8_MMA(1, 0, At, B0); PG8_MMA(1, 1, At, B1); PG8_BAR; PG8_SCHED;
        }
        if (wr == 0) PG8_BAR;
        E(acc, cur, wr, wc, fr, fq);
        if (!has_next) break;
#pragma unroll
        for (int a = 0; a < 2; ++a)
#pragma unroll
            for (int b = 0; b < 2; ++b)
#pragma unroll
                for (int m = 0; m < 4; ++m)
#pragma unroll
                    for (int n = 0; n < 2; ++n) acc[a][b][m][n] = (f32x4){0.f, 0.f, 0.f, 0.f};
        cur = nxt; cA = nA; cB = nB; cpf = npf; chB = nhB; ++ui;
        if (wr == 1) PG8_BAR;
    }
    PG8_WAIT_V(0);
    PG8_BAR;
#undef PG8_SA
#undef PG8_SB
#undef PG8_STAGE2
#undef PG8_STAGEA
#undef PG8_STAGEB
#undef PG8_LDA
#undef PG8_LDB
#undef PG8_MMA
#undef PG8_WAIT_V
#undef PG8_WAIT_L
#undef PG8_BAR
#undef PG8_SCHED
}
}

struct MArgs {
    const float* in[23]; float* out; unsigned char* ws; int ph_lo, ph_hi;
};
struct Frame {
    LAS unsigned char* lds;
    volatile LAS unsigned* MISC;
    unsigned* ctl;
    int tid, lane, wave, G, gw, NGW;
    unsigned char* ws;
};

__device__ __forceinline__ void p0_transpose_item(const float* W, int ldw, int c0, int ncols, int K, bf16_t* WT, int row_off, LAS float* scr, int item, int lane) {
    const int nblk = ncols / 32, kb = item / nblk, nb = item % nblk, k0 = 64 * kb, n0 = 32 * nb;
#pragma unroll 8
    for (int i = 0; i < 32; ++i) { const int kk = 2 * i + (lane >> 5); scr[kk * 33 + (lane & 31)] = W[(size_t)(k0 + kk) * ldw + c0 + n0 + (lane & 31)]; }
    LDS_WAIT(); asm volatile("" ::: "memory");
    const int c = lane & 7;
#pragma unroll
    for (int j = 0; j < 4; ++j) { const int n = (lane >> 3) + 8 * j; const LAS float* s = scr + (8 * c) * 33 + n;
        u32x4 o; o.x = pk2(s[0 * 33], s[1 * 33]); o.y = pk2(s[2 * 33], s[3 * 33]); o.z = pk2(s[4 * 33], s[5 * 33]); o.w = pk2(s[6 * 33], s[7 * 33]);
        *(u32x4*)(WT + (size_t)(row_off + n0 + n) * K + k0 + 8 * c) = o; }
    LDS_WAIT(); asm volatile("" ::: "memory");
}
__device__ __forceinline__ void p0_fold_item(const float* Win, bf16_t* WinT, LAS float* scr  , int item, int lane) {
    const int g = item & 3, k0 = (item >> 2) * 32;
#pragma unroll 8
    for (int i = 0; i < 32; ++i) scr[i * 65 + lane] = Win[(size_t)(k0 + i) * EVEN_IN + 2304 + g * 64 + lane];
    LDS_WAIT(); asm volatile("" ::: "memory");
    float ac[32], as[32];
#pragma unroll
    for (int i = 0; i < 32; ++i) { ac[i] = 0.f; as[i] = 0.f; }
    for (int c = 0; c < 64; ++c) {
        const float ang = (float)((lane * c) & 63) * (1.0f / 32.0f);
        const float cs = cospif(ang), sn = sinpif(ang);
#pragma unroll
        for (int i = 0; i < 32; ++i) { const float w = scr[i * 65 + c]; ac[i] += w * cs; as[i] += w * sn; }
    }
    bf16_t* rc = WinT + (size_t)(2304 + g * 64 + lane) * D + k0;
    bf16_t* rs = rc + (size_t)256 * D;
#pragma unroll
    for (int i = 0; i < 32; i += 8) {
        u32x4 o; o.x = pk2(ac[i], ac[i + 1]); o.y = pk2(ac[i + 2], ac[i + 3]); o.z = pk2(ac[i + 4], ac[i + 5]); o.w = pk2(ac[i + 6], ac[i + 7]); *(u32x4*)(rc + i) = o;
        u32x4 p; p.x = pk2(as[i], as[i + 1]); p.y = pk2(as[i + 2], as[i + 3]); p.z = pk2(as[i + 4], as[i + 5]); p.w = pk2(as[i + 6], as[i + 7]); *(u32x4*)(rs + i) = p;
    }
    LDS_WAIT(); asm volatile("" ::: "memory");
}
__device__ __forceinline__ void cvt_row(const float* src, bf16_t* dst, int lane) {
    const f32x4* s = (const f32x4*)src + lane; unsigned long long* o8 = (unsigned long long*)dst + lane;
    f32x4 v[4];
#pragma unroll
    for (int j = 0; j < 4; ++j) v[j] = s[64 * j];
#pragma unroll
    for (int j = 0; j < 4; ++j) o8[64 * j] = (unsigned long long)pk2(v[j].x, v[j].y) | ((unsigned long long)pk2(v[j].z, v[j].w) << 32);
}
__device__ __forceinline__ void normmod_row(const float* xrow, const float* g, const float* sh, const float* sc, bf16_t* orow, int lane) {
    const f32x4* xr = (const f32x4*)xrow + lane;
    f32x4 v[4]; float s = 0.f;
#pragma unroll
    for (int j = 0; j < 4; ++j) { v[j] = xr[64 * j]; s += (v[j].x * v[j].x + v[j].y * v[j].y) + (v[j].z * v[j].z + v[j].w * v[j].w); }
    const float r = rsqrtf(wave_sum(s) * (1.f / D) + EPS);
    unsigned long long* o8 = (unsigned long long*)orow + lane;
#pragma unroll
    for (int j = 0; j < 4; ++j) {
        const int c0 = (lane + 64 * j) * 4;
        const f32x4 gg = *(const f32x4*)(g + c0), scv = *(const f32x4*)(sc + c0), shv = *(const f32x4*)(sh + c0);
        const f32x4 o = v[j] * r * gg * (scv + 1.0f) + shv;
        o8[64 * j] = (unsigned long long)pk2(o.x, o.y) | ((unsigned long long)pk2(o.z, o.w) << 32);
    }
}

struct InProjOrder {
    int G, c; const char* H; const char* HC; const char* W;
    __device__ __forceinline__ bool next(int i, pg8::Unit& u) const {
        int id = i * G + c;
        const size_t rt = (size_t)256 * D * 2;
        u.bperm = 0;
        if (id < 384) { const int pm = id / 6, j = id % 6; u.kind = j < 3 ? 0 : 1; u.pm = pm; u.pn = j % 3; u.A = H + pm * rt; u.B = W + (size_t)j * rt; return true; }
        id -= 384;
        if (id < 192) { const int pn = id / 3, pm = id % 3; u.kind = 3; u.pm = pm; u.pn = pn; u.A = W + (size_t)(6 + pm) * rt; u.B = H + pn * rt; return true; }
        id -= 192;
        if (id < 128) { const int pn = id / 2, pm = id % 2; u.kind = 5; u.pm = pm; u.pn = pn; u.bperm = 1; u.A = W + (size_t)(9 + pm) * rt;
            u.B = H + ((size_t)(pn >> 4) * L + 4 * (pn & 15)) * D * 2; return true; }
        id -= 128;
        if (id < 12) { const int pm = id / 3, pn = id % 3; u.kind = 2; u.pm = pm; u.pn = pn; u.A = HC + pm * rt; u.B = W + (size_t)(3 + pn) * rt; return true; }
        id -= 12;
        if (id < 12) { const int pn = id / 3, pm = id % 3; u.kind = 4; u.pm = pm; u.pn = pn; u.A = W + (size_t)(6 + pm) * rt; u.B = HC + pn * rt; return true; }
        return false;
    }
};
struct InProjEpi {
    bf16_t* QB; bf16_t* KB; bf16_t* VT; bf16_t* FTP; unsigned* km2; const LAS f32x2* rope;
    __device__ __forceinline__ void operator()(const f32x4 (&acc)[2][2][4][2], const pg8::Unit& u, int wr, int wc, int fr, int fq) const {
        const int kind = u.kind;
        asm volatile("" : "+v"(fr), "+v"(fq));
        asm volatile("" : "+s"(wr), "+s"(wc));
        if (kind <= 2) {
            float mx[2] = {0.f, 0.f};
#pragma unroll
            for (int ai = 0; ai < 2; ++ai)
#pragma unroll
                for (int m = 0; m < 4; ++m) {
                    const int r = u.pm * 256 + ai * 128 + wr * 64 + m * 16 + fr;
                    const int tt = r & (L - 1);
                    const int pos = (wc & 1) ? (tt & 63) : (tt >> 6);
                    f32x2 cs[4];
#pragma unroll
                    for (int i = 0; i < 4; ++i) cs[i] = rope[pos * 16 + 4 * fq + i];
                    bf16_t* dst;
                    if (kind == 0) dst = QB + (size_t)r * 768;
                    else if (kind == 1) dst = KB + ((size_t)(r >> 12) * KVLEN + CTX + tt) * 768;
                    else dst = KB + ((size_t)(r >> 8) * KVLEN + (r & 255)) * 768;
#pragma unroll
                    for (int bj = 0; bj < 2; ++bj) {
                        f32x4 x0 = acc[ai][bj][m][0], x1 = acc[ai][bj][m][1];
                        if (kind != 2) {
#pragma unroll
                            for (int i = 0; i < 4; ++i) { const float a = x0[i], b = x1[i]; x0[i] = a * cs[i].x - b * cs[i].y; x1[i] = b * cs[i].x + a * cs[i].y; }
                        }
                        if (kind == 0) { x0 = x0 * C2; x1 = x1 * C2; }
                        else {
                            float ss = (x0[0] * x0[0] + x0[1] * x0[1]) + (x0[2] * x0[2] + x0[3] * x0[3]) + (x1[0] * x1[0] + x1[1] * x1[1]) + (x1[2] * x1[2] + x1[3] * x1[3]);
                            ss += __shfl_xor(ss, 16); ss += __shfl_xor(ss, 32);
                            mx[bj] = fmaxf(mx[bj], ss);
                        }
                        const int col = u.pn * 256 + bj * 128 + wc * 32 + 4 * fq;
                        u32x2 w0; w0.x = pk2(x0[0], x0[1]); w0.y = pk2(x0[2], x0[3]); *(u32x2*)(dst + col) = w0;
                        u32x2 w1; w1.x = pk2(x1[0], x1[1]); w1.y = pk2(x1[2], x1[3]); *(u32x2*)(dst + col + 16) = w1;
                    }
                }
            if (kind != 0) {
                const int b = (kind == 1) ? (u.pm >> 4) : u.pm;
#pragma unroll
                for (int bj = 0; bj < 2; ++bj) {
                    float v = mx[bj];
                    v = fmaxf(v, __shfl_xor(v, 1)); v = fmaxf(v, __shfl_xor(v, 2)); v = fmaxf(v, __shfl_xor(v, 4)); v = fmaxf(v, __shfl_xor(v, 8));
                    const int hm = 4 * u.pn + 2 * bj + (wc >> 1);
                    if ((threadIdx.x & 63) == 0) atomicMax(km2 + (b * 12 + hm) * 2 + (wc & 1), __float_as_uint(v));
                }
            }
        } else if (kind <= 4) {
#pragma unroll
            for (int ai = 0; ai < 2; ++ai)
#pragma unroll
                for (int m = 0; m < 4; ++m) {
                    const int rr = u.pm * 256 + ai * 128 + wr * 64 + m * 16 + fr;
#pragma unroll
                    for (int bj = 0; bj < 2; ++bj)
#pragma unroll
                        for (int n = 0; n < 2; ++n) {
                            const int cc = u.pn * 256 + bj * 128 + wc * 32 + n * 16 + 4 * fq;
                            size_t off;
                            if (kind == 3) off = ((size_t)(cc >> 12) * 768 + rr) * KVLEN + CTX + (cc & (L - 1));
                            else off = ((size_t)(cc >> 8) * 768 + rr) * KVLEN + (cc & 255);
                            const f32x4 x = acc[ai][bj][m][n];
                            u32x2 w; w.x = pk2(x[0], x[1]); w.y = pk2(x[2], x[3]); *(u32x2*)(VT + off) = w;
                        }
                }
        } else {
            const int b = u.pn >> 4, pnl = u.pn & 15;
#pragma unroll
            for (int ai = 0; ai < 2; ++ai)
#pragma unroll
                for (int m = 0; m < 4; ++m) {
                    const int rr = u.pm * 256 + ai * 128 + wr * 64 + m * 16 + fr;
                    const int ri = rr >> 8, cg = (rr >> 3) & 31, col = rr & 7;
#pragma unroll
                    for (int bj = 0; bj < 2; ++bj)
#pragma unroll
                        for (int n = 0; n < 2; ++n) {
                            const int v = bj * 128 + wc * 32 + n * 16 + 4 * fq;
                            const int n2 = 4 * pnl + (v >> 6), n1 = v & 63;
                            const size_t off = (((size_t)(b * 32 + cg) * 512) + n2 * 8 + col) * 128 + ri * 64 + n1;
                            const f32x4 x = acc[ai][bj][m][n];
                            u32x2 w; w.x = pk2(x[0], x[1]); w.y = pk2(x[2], x[3]); *(u32x2*)(FTP + off) = w;
                        }
                }
        }
    }
};


typedef float f32x16 __attribute__((ext_vector_type(16)));
constexpr int AT_KP = 272, AT_VP = 136, AT_TILE = 64 * AT_KP;
constexpr int AT_K0 = 0, AT_V0 = 2 * AT_TILE, AT_L = 4 * AT_TILE, AT_STG_P = 132;
__device__ __forceinline__ int crow16(int r, int hi) { return (r & 3) + 8 * (r >> 2) + 4 * hi; }
__device__ __forceinline__ bf16x8 pack8(const f32x16& p, int b) {
    u32x4 w; w.x = pk2(p[b], p[b + 1]); w.y = pk2(p[b + 2], p[b + 3]); w.z = pk2(p[b + 4], p[b + 5]); w.w = pk2(p[b + 6], p[b + 7]);
    return __builtin_bit_cast(bf16x8, w);
}
__device__ __forceinline__ void attn_phase(const Frame& F, const bf16_t* __restrict__ QB, const bf16_t* __restrict__ KB, const bf16_t* __restrict__ VT,
                                           const unsigned* km2, const float* lamp, const float* head_g, bf16_t* MIX) {
    const int tid = F.tid, lane = F.lane, w = F.wave, m = w >> 2, qs = w & 3, q = lane & 31, hi = lane >> 5;
    LAS unsigned char* lds = F.lds;
    const int vcu = (F.G % 8 == 0) ? ((int)(blockIdx.x % 8) * (F.G / 8) + (int)(blockIdx.x / 8)) : (int)blockIdx.x;
    const float lam = lamp[0];
    const int kr0 = tid >> 4, kc = tid & 15;
    const int ve0 = tid >> 3, vc = tid & 7;
    for (int it = 0;; ++it) {
        const int u = it * F.G + vcu; if (u >= 768) break;
        const int bh = u >> 5, qblk = u & 31, b = bh / 6, h = bh % 6;
        const int tok0 = b * L + qblk * 128 + qs * 32;
        bf16x8 qf[4];
        { const bf16_t* qp = QB + (size_t)(tok0 + q) * 768 + h * 128 + m * 64 + hi * 8;
#pragma unroll
          for (int ks = 0; ks < 4; ++ks) qf[ks] = *(const bf16x8*)(qp + ks * 16); }
        float negb;
        { float ss = 0.f;
#pragma unroll
          for (int ks = 0; ks < 4; ++ks)
#pragma unroll
              for (int j = 0; j < 8; ++j) { const float v = bf2f((unsigned short)qf[ks][j]); ss += v * v; }
          ss += __shfl_xor(ss, 32);
          const float k2 = __uint_as_float(km2[(b * 12 + 2 * h + m) * 2]) + __uint_as_float(km2[(b * 12 + 2 * h + m) * 2 + 1]);
          negb = -sqrtf(ss * k2); }
        const bf16_t* kg = KB + ((size_t)b * KVLEN + kr0) * 768 + h * 128 + kc * 8;
        const bf16_t* vg = VT + ((size_t)b * 768 + h * 128 + ve0) * KVLEN + vc * 8;
        u32x4 sk0, sk1, sv0, sv1;
        sk0 = *(const u32x4*)kg; sk1 = *(const u32x4*)(kg + (size_t)32 * 768); sv0 = *(const u32x4*)vg; sv1 = *(const u32x4*)(vg + (size_t)64 * KVLEN);
        __syncthreads();
        {   LAS unsigned char* kb = lds + AT_K0, *vb = lds + AT_V0;
            *(LAS u32x4*)(kb + kr0 * AT_KP + kc * 16) = sk0; *(LAS u32x4*)(kb + (kr0 + 32) * AT_KP + kc * 16) = sk1;
            *(LAS u32x2*)(vb + ve0 * AT_VP + vc * 16) = (u32x2){sv0.x, sv0.y}; *(LAS u32x2*)(vb + ve0 * AT_VP + vc * 16 + 8) = (u32x2){sv0.z, sv0.w};
            *(LAS u32x2*)(vb + (ve0 + 64) * AT_VP + vc * 16) = (u32x2){sv1.x, sv1.y}; *(LAS u32x2*)(vb + (ve0 + 64) * AT_VP + vc * 16 + 8) = (u32x2){sv1.z, sv1.w}; }
        __syncthreads();
        f32x16 o[4];
#pragma unroll
        for (int e = 0; e < 4; ++e)
#pragma unroll
            for (int r = 0; r < 16; ++r) o[e][r] = 0.f;
        float l = 0.f;
        constexpr int NT = KVLEN / 64;
        for (int t = 0; t < NT; ++t) {
            const int cb = t & 1;
            if (t + 1 < NT) {
                const bf16_t* kg1 = kg + (size_t)(t + 1) * 64 * 768; const bf16_t* vg1 = vg + (t + 1) * 64;
                sk0 = *(const u32x4*)kg1; sk1 = *(const u32x4*)(kg1 + (size_t)32 * 768); sv0 = *(const u32x4*)vg1; sv1 = *(const u32x4*)(vg1 + (size_t)64 * KVLEN);
            }
            const LAS unsigned char* kb = lds + AT_K0 + cb * AT_TILE + q * AT_KP + (m * 64 + hi * 8) * 2;
            const LAS unsigned char* vb = lds + AT_V0 + cb * AT_TILE + q * AT_VP + hi * 8;
            f32x16 p0, p1;
#pragma unroll
            for (int r = 0; r < 16; ++r) { p0[r] = negb; p1[r] = negb; }
#pragma unroll
            for (int ks = 0; ks < 4; ++ks) {
                const bf16x8 k0 = *(const LAS bf16x8*)(kb + ks * 32), k1 = *(const LAS bf16x8*)(kb + 32 * AT_KP + ks * 32);
                p0 = __builtin_amdgcn_mfma_f32_32x32x16_bf16(k0, qf[ks], p0, 0, 0, 0);
                p1 = __builtin_amdgcn_mfma_f32_32x32x16_bf16(k1, qf[ks], p1, 0, 0, 0);
            }
            float sa = 0.f, sb = 0.f;
#pragma unroll
            for (int r = 0; r < 16; ++r) { p0[r] = __builtin_amdgcn_exp2f(p0[r]); p1[r] = __builtin_amdgcn_exp2f(p1[r]); sa += p0[r]; sb += p1[r]; }
            l += sa + sb;
            bf16x8 pa[4]; pa[0] = pack8(p0, 0); pa[1] = pack8(p0, 8); pa[2] = pack8(p1, 0); pa[3] = pack8(p1, 8);
#pragma unroll
            for (int eb = 0; eb < 4; ++eb)
#pragma unroll
                for (int s = 0; s < 4; ++s) {
                    const LAS unsigned char* vp = vb + eb * 32 * AT_VP + (32 * (s >> 1) + 16 * (s & 1)) * 2;
                    const u32x2 lo = *(const LAS u32x2*)vp, h2 = *(const LAS u32x2*)(vp + 16);
                    const u32x4 fr4 = (u32x4){lo.x, lo.y, h2.x, h2.y};
                    o[eb] = __builtin_amdgcn_mfma_f32_32x32x16_bf16(pa[s], __builtin_bit_cast(bf16x8, fr4), o[eb], 0, 0, 0);
                }
            if (t + 1 < NT) {
                LAS unsigned char* kw = lds + AT_K0 + (cb ^ 1) * AT_TILE, *vw = lds + AT_V0 + (cb ^ 1) * AT_TILE;
                *(LAS u32x4*)(kw + kr0 * AT_KP + kc * 16) = sk0; *(LAS u32x4*)(kw + (kr0 + 32) * AT_KP + kc * 16) = sk1;
                *(LAS u32x2*)(vw + ve0 * AT_VP + vc * 16) = (u32x2){sv0.x, sv0.y}; *(LAS u32x2*)(vw + ve0 * AT_VP + vc * 16 + 8) = (u32x2){sv0.z, sv0.w};
                *(LAS u32x2*)(vw + (ve0 + 64) * AT_VP + vc * 16) = (u32x2){sv1.x, sv1.y}; *(LAS u32x2*)(vw + (ve0 + 64) * AT_VP + vc * 16 + 8) = (u32x2){sv1.z, sv1.w};
            }
            __syncthreads();
        }
        l += __shfl_xor(l, 32);
        LAS float* lrow = (LAS float*)(lds + AT_L) + w * 32;
        if (hi == 0) lrow[q] = l;
        LDS_WAIT(); asm volatile("" ::: "memory");
        LAS float* stg = (LAS float*)lds + (size_t)qs * 32 * AT_STG_P;
        if (m == 1) {
#pragma unroll
            for (int r = 0; r < 16; ++r) { const int row = crow16(r, hi); const float sc = lam / lrow[row];
#pragma unroll
                for (int eb = 0; eb < 4; ++eb) stg[row * AT_STG_P + eb * 32 + q] = o[eb][r] * sc; }
        }
        __syncthreads();
        if (m == 0) {
#pragma unroll
            for (int r = 0; r < 16; ++r) { const int row = crow16(r, hi); const float sc = 1.0f / lrow[row];
#pragma unroll
                for (int eb = 0; eb < 4; ++eb) { const int a = row * AT_STG_P + eb * 32 + q; stg[a] = o[eb][r] * sc - stg[a]; } }
        }
        __syncthreads();
        {
            const f32x2 hg = *(const f32x2*)(head_g + 2 * lane);
#pragma unroll 4
            for (int rr = 0; rr < 16; ++rr) {
                const int row = w * 16 + rr;
                const f32x2 v = *(const LAS f32x2*)((LAS float*)lds + (size_t)row * AT_STG_P + 2 * lane);
                const float ss = wave_sum(v.x * v.x + v.y * v.y);
                const float rn = rsqrtf(ss * (1.f / 128.f) + EPS) * 0.8f;
                *(unsigned*)(MIX + (size_t)(b * L + qblk * 128 + row) * D + h * 128 + 2 * lane) = pk2(v.x * rn * hg.x, v.y * rn * hg.y);
            }
        }
    }
    __syncthreads();
}


struct StdOrder {
    int G, c, nN, total; const char* A; const char* Bt;
    __device__ __forceinline__ bool next(int i, pg8::Unit& u) const {
        const int id = i * G + c; if (id >= total) return false;
        const size_t rt = (size_t)256 * D * 2;
        u.pm = id / nN; u.pn = id % nN; u.kind = 0; u.bperm = 0; u.A = A + u.pm * rt; u.B = Bt + u.pn * rt; return true;
    }
};
struct EpiResid {
    const float* res; float* out; const float* gate;
    __device__ __forceinline__ void operator()(const f32x4 (&acc)[2][2][4][2], const pg8::Unit& u, int wr, int wc, int fr, int fq) const {
        asm volatile("" : "+v"(fr), "+v"(fq)); asm volatile("" : "+s"(wr), "+s"(wc));
        const float* g = gate + (size_t)(u.pm >> 4) * 6 * D;
#pragma unroll
        for (int ai = 0; ai < 2; ++ai)
#pragma unroll
            for (int m = 0; m < 4; ++m) {
                const size_t r = (size_t)u.pm * 256 + ai * 128 + wr * 64 + m * 16 + fr;
#pragma unroll
                for (int bj = 0; bj < 2; ++bj)
#pragma unroll
                    for (int n = 0; n < 2; ++n) {
                        const int col = u.pn * 256 + bj * 128 + wc * 32 + n * 16 + 4 * fq;
                        const f32x4 rv = *(const f32x4*)(res + r * D + col), gv = *(const f32x4*)(g + col);
                        *(f32x4*)(out + r * D + col) = rv + gv * acc[ai][bj][m][n];
                    }
            }
    }
};
struct EpiStoreBf16 {
    bf16_t* O; int ldc;
    __device__ __forceinline__ void operator()(const f32x4 (&acc)[2][2][4][2], const pg8::Unit& u, int wr, int wc, int fr, int fq) const {
        asm volatile("" : "+v"(fr), "+v"(fq)); asm volatile("" : "+s"(wr), "+s"(wc));
#pragma unroll
        for (int ai = 0; ai < 2; ++ai)
#pragma unroll
            for (int m = 0; m < 4; ++m) {
                const size_t r = (size_t)u.pm * 256 + ai * 128 + wr * 64 + m * 16 + fr;
#pragma unroll
                for (int bj = 0; bj < 2; ++bj)
#pragma unroll
                    for (int n = 0; n < 2; ++n) {
                        const int col = u.pn * 256 + bj * 128 + wc * 32 + n * 16 + 4 * fq;
                        const f32x4 x = acc[ai][bj][m][n];
                        u32x2 w; w.x = pk2(x[0], x[1]); w.y = pk2(x[2], x[3]); *(u32x2*)(O + r * ldc + col) = w;
                    }
            }
    }
};
__device__ __forceinline__ float gelu_fast(float x) {
    const float u2 = -2.0f * 1.4426950408889634f * 0.7978845608028654f * (x + 0.044715f * x * x * x);
    return x * __builtin_amdgcn_rcpf(1.0f + __builtin_amdgcn_exp2f(u2));
}
struct OddInOrder {
    int G, c; const char* H; const char* W;
    __device__ __forceinline__ bool next(int i, pg8::Unit& u) const {
        int id = i * G + c; const size_t rt = (size_t)256 * D * 2; u.bperm = 0;
        if (id < 256) { u.kind = 0; u.pm = id >> 2; u.pn = id & 3; u.A = H + u.pm * rt; u.B = W + u.pn * rt; return true; }
        id -= 256;
        if (id < 256) { u.kind = 1; u.pn = id >> 2; u.pm = id & 3; u.A = W + (size_t)(4 + u.pm) * rt; u.B = H + u.pn * rt; return true; }
        return false;
    }
};
struct EpiOddIn {
    bf16_t* ZU; bf16_t* ZVT; const float* bias; float* rsq;
    __device__ __forceinline__ void operator()(const f32x4 (&acc)[2][2][4][2], const pg8::Unit& u, int wr, int wc, int fr, int fq) const {
        asm volatile("" : "+v"(fr), "+v"(fq)); asm volatile("" : "+s"(wr), "+s"(wc));
        if (u.kind == 0) {
#pragma unroll
            for (int bj = 0; bj < 2; ++bj)
#pragma unroll
                for (int n = 0; n < 2; ++n) {
                    const int col = u.pn * 256 + bj * 128 + wc * 32 + n * 16 + 4 * fq;
                    const f32x4 bv = *(const f32x4*)(bias + col);
#pragma unroll
                    for (int ai = 0; ai < 2; ++ai)
#pragma unroll
                        for (int m = 0; m < 4; ++m) {
                            const size_t r = (size_t)u.pm * 256 + ai * 128 + wr * 64 + m * 16 + fr;
                            const f32x4 x = acc[ai][bj][m][n] + bv;
                            u32x2 w; w.x = pk2(gelu_fast(x[0]), gelu_fast(x[1])); w.y = pk2(gelu_fast(x[2]), gelu_fast(x[3])); *(u32x2*)(ZU + r * 1024 + col) = w;
                        }
                }
        } else {
#pragma unroll
            for (int bj = 0; bj < 2; ++bj)
#pragma unroll
                for (int n = 0; n < 2; ++n) {
                    const int tk = u.pn * 256 + bj * 128 + wc * 32 + n * 16 + 4 * fq;
                    f32x4 ss = (f32x4){0.f, 0.f, 0.f, 0.f};
#pragma unroll
                    for (int ai = 0; ai < 2; ++ai)
#pragma unroll
                        for (int m = 0; m < 4; ++m) {
                            const int rr = u.pm * 256 + ai * 128 + wr * 64 + m * 16 + fr;
                            const float bb = bias[1024 + rr];
                            f32x4 x = acc[ai][bj][m][n] + bb;
                            x[0] = gelu_fast(x[0]); x[1] = gelu_fast(x[1]); x[2] = gelu_fast(x[2]); x[3] = gelu_fast(x[3]);
                            ss += x * x;
                            u32x2 w; w.x = pk2(x[0], x[1]); w.y = pk2(x[2], x[3]); *(u32x2*)(ZVT + (size_t)rr * NTOK + tk) = w;
                        }
#pragma unroll
                    for (int i = 0; i < 4; ++i) { float v = ss[i]; v += __shfl_xor(v, 1); v += __shfl_xor(v, 2); v += __shfl_xor(v, 4); v += __shfl_xor(v, 8); ss[i] = v; }
                    if (fr == 0) {
#pragma unroll
                        for (int i = 0; i < 4; ++i) atomicAdd(rsq + tk + i, ss[i]);
                    }
                }
        }
    }
};

__device__ __forceinline__ void sgu_phase(const Frame& F, const bf16_t* __restrict__ ZU, const bf16_t* __restrict__ ZVT, const bf16_t* __restrict__ SW, const float* rsq,
                                          const float* ng, const float* bs, bf16_t* US) {
    const int tid = F.tid, lane = F.lane, w = F.wave, fr = lane & 15, fq = lane >> 4;
    LAS unsigned char* lds = F.lds;
    LAS float* rl = (LAS float*)(lds + 128 * 272);
    for (int it = 0;; ++it) {
        const int u = it * F.G + (int)blockIdx.x; if (u >= 1024) break;
        const int chunk = u >> 3, g = u & 7, tok0 = chunk * 128;
        __syncthreads();
#pragma unroll
        for (int i = 0; i < 4; ++i) { const int ch = tid + 512 * i, row = ch >> 4, cc = ch & 15;
            *(LAS u32x4*)(lds + row * 272 + cc * 16) = *(const u32x4*)(ZVT + (size_t)(g * 128 + row) * NTOK + tok0 + cc * 8); }
        if (tid < 128) rl[tid] = rsqrtf(rsq[tok0 + tid] * (1.f / 1024.f) + EPS);
        __syncthreads();
        bf16x8 af[4];
#pragma unroll
        for (int ks = 0; ks < 4; ++ks) {
            const bf16x8 a = *(const bf16x8*)(SW + ((size_t)g * 128 + 16 * w + fr) * 128 + ks * 32 + fq * 8);
            float v[8];
#pragma unroll
            for (int j = 0; j < 8; ++j) v[j] = bf2f((unsigned short)a[j]) * rl[ks * 32 + fq * 8 + j];
            u32x4 p; p.x = pk2(v[0], v[1]); p.y = pk2(v[2], v[3]); p.z = pk2(v[4], v[5]); p.w = pk2(v[6], v[7]);
            af[ks] = __builtin_bit_cast(bf16x8, p);
        }
        f32x4 acc[8];
#pragma unroll
        for (int nt = 0; nt < 8; ++nt) {
            acc[nt] = (f32x4){0.f, 0.f, 0.f, 0.f};
#pragma unroll
            for (int ks = 0; ks < 4; ++ks) {
                const bf16x8 bfr = *(const LAS bf16x8*)(lds + (nt * 16 + fr) * 272 + (ks * 32 + fq * 8) * 2);
                acc[nt] = __builtin_amdgcn_mfma_f32_16x16x32_bf16(af[ks], bfr, acc[nt], 0, 0, 0);
            }
        }
#pragma unroll
        for (int nt = 0; nt < 8; ++nt) {
            const int c = g * 128 + nt * 16 + fr; const float gn = ng[c];
#pragma unroll
            for (int rg = 0; rg < 4; ++rg) {
                const int p = 16 * w + 4 * fq + rg;
                const float s = acc[nt][rg] * gn + bs[g * 128 + p];
                const size_t a = (size_t)(tok0 + p) * 1024 + c;
                US[a] = (bf16_t)f2bf(bf2f(ZU[a]) * s);
            }
        }
    }
    __syncthreads();
}

__device__ __forceinline__ void ins16(float (&Lst)[16], float v) {
#pragma unroll
    for (int j = 15; j >= 1; --j) Lst[j] = __builtin_amdgcn_fmed3f(Lst[j - 1], v, Lst[j]);
    Lst[0] = fmaxf(Lst[0], v);
}
__device__ __forceinline__ void topk_phase(const Frame& F, const bf16_t* __restrict__ PQ, const bf16_t* __restrict__ KEYS  , int* IDX, float* GATE) {
    const int tid = F.tid, lane = F.lane, w = F.wave, fr = lane & 15, fq = lane >> 4;
    LAS float* S = (LAS float*)F.lds;
    for (int it = 0;; ++it) {
        const int u = it * F.G + (int)blockIdx.x; if (u >= 1024) break;
        const int tt = u >> 3, h = u & 7, tok0 = tt * 128;
        __syncthreads();
        {
            const int s = w >> 2;
            bf16x8 bfr[2][4];
#pragma unroll
            for (int n = 0; n < 2; ++n)
#pragma unroll
                for (int ks = 0; ks < 4; ++ks) bfr[n][ks] = *(const bf16x8*)(KEYS + (((size_t)h * 2 + s) * 128 + (2 * (w & 3) + n) * 16 + fr) * 128 + ks * 32 + fq * 8);
#pragma unroll 2
            for (int mt = 0; mt < 8; ++mt) {
                bf16x8 afr[4];
#pragma unroll
                for (int ks = 0; ks < 4; ++ks) afr[ks] = *(const bf16x8*)(PQ + (size_t)(tok0 + mt * 16 + fr) * PEER_QW + h * 256 + s * 128 + ks * 32 + fq * 8);
#pragma unroll
                for (int n = 0; n < 2; ++n) {
                    f32x4 acc = (f32x4){0.f, 0.f, 0.f, 0.f};
#pragma unroll
                    for (int ks = 0; ks < 4; ++ks) acc = __builtin_amdgcn_mfma_f32_16x16x32_bf16(afr[ks], bfr[n][ks], acc, 0, 0, 0);
                    const int key = (2 * (w & 3) + n) * 16 + fr;
#pragma unroll
                    for (int rg = 0; rg < 4; ++rg) S[((mt * 16 + 4 * fq + rg) * 2 + s) * 129 + key] = acc[rg];
                }
            }
        }
        __syncthreads();
        if (tid < 256) {
            const LAS float* row = S + tid * 129;
            float Lst[16];
#pragma unroll
            for (int j = 0; j < 16; ++j) Lst[j] = -INFINITY;
            for (int i = 0; i < 128; ++i) {
                const unsigned b = (__float_as_uint(row[i]) & ~127u) | (unsigned)(127 - i);
                ins16(Lst, __uint_as_float(b));
            }
            float sc[16]; int ix[16];
#pragma unroll
            for (int j = 0; j < 16; ++j) { ix[j] = 127 - (int)(__float_as_uint(Lst[j]) & 127u); sc[j] = row[ix[j]]; }
            LAS float* o = S + tid * 129;
#pragma unroll
            for (int j = 0; j < 16; ++j) { o[j] = sc[j]; o[16 + j] = __int_as_float(ix[j]); }
        }
        __syncthreads();
        if (tid < 128) {
            const LAS float* r0 = S + (tid * 2) * 129; const LAS float* r1 = r0 + 129;
            float s1[16], s2[16];
#pragma unroll
            for (int j = 0; j < 16; ++j) { s1[j] = r0[j]; s2[j] = r1[j]; }
            float Lst[16];
#pragma unroll
            for (int j = 0; j < 16; ++j) Lst[j] = -INFINITY;
#pragma unroll
            for (int a = 0; a < 16; ++a)
#pragma unroll
                for (int b = 0; b < 16; ++b)
                    if ((a + 1) * (b + 1) <= 16) {
                        const unsigned bits = (__float_as_uint(s1[a] + s2[b]) & ~255u) | (unsigned)(255 - (a * 16 + b));
                        ins16(Lst, __uint_as_float(bits));
                    }
            float sc[16]; int ex[16]; float mx = -INFINITY;
#pragma unroll
            for (int j = 0; j < 16; ++j) {
                const int ci = 255 - (int)(__float_as_uint(Lst[j]) & 255u), a = ci >> 4, b = ci & 15;
                sc[j] = r0[a] + r1[b]; ex[j] = __float_as_int(r0[16 + a]) * 128 + __float_as_int(r1[16 + b]); mx = fmaxf(mx, sc[j]);
            }
            float sum = 0.f;
#pragma unroll
            for (int j = 0; j < 16; ++j) { sc[j] = __expf(sc[j] - mx); sum += sc[j]; }
            const float inv = 1.0f / sum;
            int* ip = IDX + (size_t)(tok0 + tid) * 128 + h * 16; float* gp = GATE + (size_t)(tok0 + tid) * 128 + h * 16;
#pragma unroll
            for (int j = 0; j < 16; j += 4) { *(int4*)(ip + j) = make_int4(ex[j], ex[j + 1], ex[j + 2], ex[j + 3]); *(float4*)(gp + j) = make_float4(sc[j] * inv, sc[j + 1] * inv, sc[j + 2] * inv, sc[j + 3] * inv); }
        }
    }
    __syncthreads();
}

__device__ __forceinline__ float dot2bf(unsigned a, unsigned b, float c) {
    typedef __bf16 bf2 __attribute__((ext_vector_type(2)));
    return __builtin_amdgcn_fdot2_f32_bf16(__builtin_bit_cast(bf2, a), __builtin_bit_cast(bf2, b), c, false);
}
template <int FUSE>
__device__ __forceinline__ void peer_apply_phase(const Frame& F, const bf16_t* __restrict__ T, const int* __restrict__ IDX, const float* __restrict__ GATE,
                                                 const bf16_t* __restrict__ EU, const bf16_t* __restrict__ EV, const float* g2mod  , float* X,
                                                 const float* ng, const float* nmod  , bf16_t* Hn) {
    const int lane = F.lane;
    const unsigned lo16 = (unsigned)lane * 16u;
    for (int tok = F.gw; tok < NTOK; tok += F.NGW) {
        const char* tb = uni_ptr((const char*)(T + (size_t)tok * D));
        const u32x4 t0 = *(const u32x4*)(tb + lo16), t1 = *(const u32x4*)(tb + 1024 + lo16);
        float acc[16];
#pragma unroll
        for (int j = 0; j < 16; ++j) acc[j] = 0.f;
        const int* ip = (const int*)uni_ptr((const char*)(IDX + (size_t)tok * 128)); const float* gp = (const float*)uni_ptr((const char*)(GATE + (size_t)tok * 128));
        for (int e0 = 0; e0 < 128; e0 += 8) {
            int ex[8]; float gt[8];
#pragma unroll
            for (int j = 0; j < 8; ++j) { ex[j] = __builtin_amdgcn_readfirstlane(ip[e0 + j]); gt[j] = __uint_as_float(__builtin_amdgcn_readfirstlane(__float_as_uint(gp[e0 + j]))); }
            float dsum[8];
            {
                u32x4 ua[8], ub[8];
#pragma unroll
                for (int j = 0; j < 8; ++j) { const char* ur = uni_ptr((const char*)(EU + (size_t)ex[j] * D)); ua[j] = *(const u32x4*)(ur + lo16); ub[j] = *(const u32x4*)(ur + 1024 + lo16); }
#pragma unroll
                for (int j = 0; j < 8; ++j) {
                    float s = dot2bf(ua[j].x, t0.x, 0.f); s = dot2bf(ua[j].y, t0.y, s); s = dot2bf(ua[j].z, t0.z, s); s = dot2bf(ua[j].w, t0.w, s);
                    s = dot2bf(ub[j].x, t1.x, s); s = dot2bf(ub[j].y, t1.y, s); s = dot2bf(ub[j].z, t1.z, s); s = dot2bf(ub[j].w, t1.w, s);
                    dsum[j] = s;
                }
            }
            __builtin_amdgcn_sched_barrier(0);
            u32x4 va[8], vb[8];
#pragma unroll
            for (int j = 0; j < 8; ++j) { const char* vr = uni_ptr((const char*)(EV + (size_t)ex[j] * D)); va[j] = *(const u32x4*)(vr + lo16); vb[j] = *(const u32x4*)(vr + 1024 + lo16); }
#pragma unroll
            for (int j = 0; j < 8; ++j) dsum[j] = wave_sum(dsum[j]);
#pragma unroll
            for (int j = 0; j < 8; ++j) {
                const float wgt = gt[j] * gelu_fast(dsum[j]);
                const unsigned wv[8] = {va[j].x, va[j].y, va[j].z, va[j].w, vb[j].x, vb[j].y, vb[j].z, vb[j].w};
#pragma unroll
                for (int q = 0; q < 8; ++q) { acc[2 * q] += wgt * __uint_as_float(wv[q] << 16); acc[2 * q + 1] += wgt * __uint_as_float(wv[q] & 0xffff0000u); }
            }
            __builtin_amdgcn_sched_barrier(0);
        }
        const int b = tok >> 12;
        const float* g2 = g2mod + (size_t)b * 6 * D;
        float* xr = X + (size_t)tok * D;
        float xn[16]; float ss = 0.f;
#pragma unroll
        for (int hlf = 0; hlf < 2; ++hlf)
#pragma unroll
            for (int q4 = 0; q4 < 2; ++q4) {
                const int c0 = hlf * 512 + lane * 8 + q4 * 4;
                const f32x4 xv = *(const f32x4*)(xr + c0), gv = *(const f32x4*)(g2 + c0);
#pragma unroll
                for (int i = 0; i < 4; ++i) { const float v = xv[i] + gv[i] * acc[hlf * 8 + q4 * 4 + i]; xn[hlf * 8 + q4 * 4 + i] = v; ss += v * v; }
            }
        if (FUSE == 0) {
#pragma unroll
            for (int hlf = 0; hlf < 2; ++hlf)
#pragma unroll
                for (int q4 = 0; q4 < 2; ++q4) { const int c0 = hlf * 512 + lane * 8 + q4 * 4, k = hlf * 8 + q4 * 4; *(f32x4*)(xr + c0) = (f32x4){xn[k], xn[k + 1], xn[k + 2], xn[k + 3]}; }
        } else {
            const float r = rsqrtf(wave_sum(ss) * (1.f / D) + EPS);
#pragma unroll
            for (int hlf = 0; hlf < 2; ++hlf)
#pragma unroll
                for (int q4 = 0; q4 < 2; ++q4) {
                    const int c0 = hlf * 512 + lane * 8 + q4 * 4, k = hlf * 8 + q4 * 4;
                    const f32x4 gg = *(const f32x4*)(ng + c0);
                    if (FUSE == 1) {
                        *(f32x4*)(xr + c0) = (f32x4){xn[k], xn[k + 1], xn[k + 2], xn[k + 3]};
                        const float* nm = nmod + (size_t)b * 6 * D;
                        const f32x4 sh = *(const f32x4*)(nm + c0), sc = *(const f32x4*)(nm + D + c0);
                        f32x4 o;
#pragma unroll
                        for (int i = 0; i < 4; ++i) o[i] = xn[k + i] * r * gg[i] * (1.f + sc[i]) + sh[i];
                        u32x2 wv; wv.x = pk2(o[0], o[1]); wv.y = pk2(o[2], o[3]); *(u32x2*)(Hn + (size_t)tok * D + c0) = wv;
                    } else {
                        f32x4 o;
#pragma unroll
                        for (int i = 0; i < 4; ++i) o[i] = xn[k + i] * r * gg[i];
                        *(f32x4*)(xr + c0) = o;
                    }
                }
        }
    }
}


constexpr int FO_P = 272;
__device__ __forceinline__ void fourier_unit(const Frame& F, int unit, const bf16_t* __restrict__ FTP, const bf16_t* __restrict__ MA, const bf16_t* __restrict__ MB, const f32x2* __restrict__ TW, bf16_t* MIX) {
    const int tid = F.tid, lane = F.lane, w = F.wave, fr = lane & 15, fq = lane >> 4;
    LAS unsigned char* lds = F.lds;
    const int b = unit >> 5, cg = unit & 31;
    __syncthreads();
    {   const bf16_t* src = FTP + (size_t)unit * 512 * 128 + tid * 8;
        LAS unsigned char* dst = lds + (tid >> 4) * FO_P + (tid & 15) * 16;
#pragma unroll
        for (int i = 0; i < 16; ++i) *(LAS u32x4*)(dst + i * 32 * FO_P) = *(const u32x4*)(src + i * 4096); }
    __syncthreads();
    {
        f32x4 acc[8][4];
#pragma unroll
        for (int mt = 0; mt < 8; ++mt)
#pragma unroll
            for (int nt = 0; nt < 4; ++nt) acc[mt][nt] = (f32x4){0.f, 0.f, 0.f, 0.f};
#pragma unroll 1
        for (int ks = 0; ks < 4; ++ks) {
            bf16x8 a[8], bb[4];
#pragma unroll
            for (int mt = 0; mt < 8; ++mt) a[mt] = *(const bf16x8*)(MA + (size_t)(16 * mt + fr) * 128 + ks * 32 + fq * 8);
#pragma unroll
            for (int nt = 0; nt < 4; ++nt) bb[nt] = *(const LAS bf16x8*)(lds + (16 * (4 * w + nt) + fr) * FO_P + (ks * 32 + fq * 8) * 2);
#pragma unroll
            for (int mt = 0; mt < 8; ++mt)
#pragma unroll
                for (int nt = 0; nt < 4; ++nt) acc[mt][nt] = __builtin_amdgcn_mfma_f32_16x16x32_bf16(a[mt], bb[nt], acc[mt][nt], 0, 0, 0);
        }
        __syncthreads();
#pragma unroll
        for (int nt = 0; nt < 4; ++nt) {
            const int n = 16 * (4 * w + nt) + fr, n2 = n >> 3, col = n & 7;
#pragma unroll
            for (int mt = 0; mt < 8; ++mt)
#pragma unroll
                for (int pr = 0; pr < 2; ++pr) {
                    const int ka = 8 * mt + 2 * fq + pr;
                    const f32x2 tw = TW[(ka * n2) & 4095];
                    const float tr = acc[mt][nt][2 * pr], ti = acc[mt][nt][2 * pr + 1];
                    *(LAS unsigned*)(lds + (ka * 8 + col) * FO_P + n2 * 4) = pk2(tr * tw.x + ti * tw.y, ti * tw.x - tr * tw.y);
                    if (pr == 1 && (mt & 1)) asm volatile("" ::: "memory");
                }
        }
    }
    __syncthreads();
    {
        f32x4 acc[4][4];
#pragma unroll
        for (int mt = 0; mt < 4; ++mt)
#pragma unroll
            for (int nt = 0; nt < 4; ++nt) acc[mt][nt] = (f32x4){0.f, 0.f, 0.f, 0.f};
#pragma unroll 1
        for (int ks = 0; ks < 4; ++ks) {
            bf16x8 a[4], bb[4];
#pragma unroll
            for (int mt = 0; mt < 4; ++mt) a[mt] = *(const bf16x8*)(MB + (size_t)(16 * mt + fr) * 128 + ks * 32 + fq * 8);
#pragma unroll
            for (int nt = 0; nt < 4; ++nt) bb[nt] = *(const LAS bf16x8*)(lds + (16 * (4 * w + nt) + fr) * FO_P + (ks * 32 + fq * 8) * 2);
#pragma unroll
            for (int mt = 0; mt < 4; ++mt)
#pragma unroll
                for (int nt = 0; nt < 4; ++nt) acc[mt][nt] = __builtin_amdgcn_mfma_f32_16x16x32_bf16(a[mt], bb[nt], acc[mt][nt], 0, 0, 0);
        }
#pragma unroll
        for (int nt = 0; nt < 4; ++nt) {
            const int cp = 16 * (4 * w + nt) + fr, ka = cp >> 3, col = cp & 7;
            bf16_t* ob = MIX + (size_t)(b * L + ka + 256 * fq) * D + 768 + cg * 8 + col;
#pragma unroll
            for (int mt = 0; mt < 4; ++mt)
#pragma unroll
                for (int rg = 0; rg < 4; ++rg) ob[(size_t)(16 * mt + rg) * 64 * D] = (bf16_t)f2bf(acc[mt][nt][rg]);
        }
    }
    __syncthreads();
}

__global__ void __launch_bounds__(NWAVES * 64, 2) mega_fwd(MArgs args) {
    extern __shared__ __attribute__((aligned(16))) unsigned char lds_raw[];
    Frame F0;
    F0.lds = (LAS unsigned char*)lds_raw;
    F0.MISC = (volatile LAS unsigned*)(F0.lds + MISC_OFF);
    F0.tid = threadIdx.x; F0.lane = F0.tid & 63; F0.wave = __builtin_amdgcn_readfirstlane(F0.tid >> 6);
    F0.G = gridDim.x; F0.gw = blockIdx.x * NWAVES + F0.wave; F0.NGW = F0.G * NWAVES;
    F0.ws = args.ws; F0.ctl = (unsigned*)(args.ws + FW_CTL);
    for (int u = F0.tid; u < 128; u += NWAVES * 64) ((LAS unsigned*)(F0.lds + MISC_OFF))[u] = 0u;
    __syncthreads();
    XcdBarrier bar = xcd_barrier_post(F0.ctl + CW_BAR, F0.MISC + 8);
    const int lo = args.ph_lo, hi = args.ph_hi;
#define IN(k) (lo <= (k) && (k) < hi)
#define SEAM(k) do { if (IN(k) && (k) + 1 < hi) xcd_barrier(bar); } while (0)
    unsigned char* ws = args.ws;
    const float* x = args.in[0]; const float* c = args.in[1]; const float* ctx = args.in[2]; const float* c_ctx = args.in[3];
    const float* ada_w = args.in[4]; const float* ada_b = args.in[5]; const float* norm1_g = args.in[6];
    const float* even_w_in = args.in[9]; const float* even_w_out = args.in[10]; const float* diff_lambda = args.in[11];
    const float* odd_w_in = args.in[13]; const float* sgu_w = args.in[16]; const float* odd_w_out = args.in[18];
    const float* peer_wq = args.in[19]; const float* peer_keys = args.in[20]; const float* peer_u = args.in[21]; const float* peer_v = args.in[22];
    float* MOD = (float*)(ws + FW_MOD);
    bf16_t* WinT = (bf16_t*)(ws + FW_WIN); bf16_t* H = (bf16_t*)(ws + FW_H); bf16_t* HC = (bf16_t*)(ws + FW_HC);

    if (IN(0)) { Frame F = F0; asm volatile("" : "+v"(F.tid), "+v"(F.lane));
        LAS float* S = (LAS float*)(F.lds + 98304);
        for (int i = F.tid; i < 5 * D; i += NWAVES * 64) { const float v = (i < 4 * D) ? c[i] : c_ctx[i - 4 * D]; S[i] = v / (1.f + __expf(-v)); }
        __syncthreads();
        for (int task = F.gw; task < 2 * 96; task += F.NGW) {
            const int l = task / 96, j = (task % 96) * 64 + F.lane;
            const float* w = ada_w + (size_t)l * D * 6 * D + j;
            float a0 = 0.f, a1 = 0.f, a2 = 0.f, a3 = 0.f, a4 = 0.f;
#pragma unroll 8
            for (int k = 0; k < D; ++k) { const float wv = w[(size_t)k * 6 * D]; a0 += S[k] * wv; a1 += S[D + k] * wv; a2 += S[2 * D + k] * wv; a3 += S[3 * D + k] * wv; a4 += S[4 * D + k] * wv; }
            const float bb = ada_b[l * 6 * D + j]; float* mo = MOD + (size_t)l * 5 * 6 * D + j;
            mo[0] = a0 + bb; mo[6 * D] = a1 + bb; mo[12 * D] = a2 + bb; mo[18 * D] = a3 + bb; mo[24 * D] = a4 + bb;
        }
        if (blockIdx.x == 0 && F.tid == 0) {
            float a = 0.f, b = 0.f;
            for (int i = 0; i < 64; ++i) { a += diff_lambda[i] * diff_lambda[64 + i]; b += diff_lambda[128 + i] * diff_lambda[192 + i]; }
            *(float*)(ws + FW_LAM) = expf(a) - expf(b) + 0.2f;
        }
        if (blockIdx.x == 1) {
            f32x2* rt = (f32x2*)(ws + FW_ROPE);
            for (int i = F.tid; i < 1024; i += NWAVES * 64) { const float ang = (float)(i >> 4) * powf(10000.0f, -(float)(i & 15) / 16.0f); rt[i] = (f32x2){cosf(ang), sinf(ang)}; }
            f32x2* tw = (f32x2*)(ws + FW_TW);
            for (int i = F.tid; i < 4096; i += NWAVES * 64) tw[i] = (f32x2){cospif((float)i / 2048.f), sinpif((float)i / 2048.f)};
        }
        if (blockIdx.x == 2) {
            bf16_t* MAo = (bf16_t*)(ws + FW_MA); bf16_t* MBo = (bf16_t*)(ws + FW_MB);
            for (int i = F.tid; i < 128 * 128; i += NWAVES * 64) {
                const int row = i >> 7, k = i & 127, ka = row >> 1, ro = row & 1, ri = k >> 6, n1 = k & 63;
                const float ang = (float)((ka * n1) & 63) * (1.0f / 32.0f), cs = cospif(ang), sn = sinpif(ang);
                const float v = (ro == 0) ? (ri == 0 ? cs : -sn) : (ri == 0 ? -sn : -cs);
                MAo[i] = (bf16_t)f2bf(v);
            }
            for (int i = F.tid; i < 64 * 128; i += NWAVES * 64) {
                const int kb = i >> 7, k = i & 127, n2 = k >> 1, ri = k & 1;
                const float ang = (float)((kb * n2) & 63) * (1.0f / 32.0f);
                MBo[i] = (bf16_t)f2bf((ri == 0 ? cospif(ang) : sinpif(ang)) * (1.0f / 512.0f));
            }
        }
        LAS float* scr = (LAS float*)(F.lds + F.wave * 8448);
        {
            constexpr int I_FOLD = 128;
            constexpr int I_WIN = 16 * 72, I_WOUT = 16 * 32, I_WQ = 16 * 64, I_OWIN = 16 * 64, I_OWOUT = 16 * 32;
            constexpr int NITEMS = I_FOLD + I_WIN + I_WOUT + 2 * I_WQ + I_OWIN + I_OWOUT;
            for (int it = F.gw; it < NITEMS; it += F.NGW) {
                int r = it;
                if (r < I_FOLD) { p0_fold_item(even_w_in, WinT, scr, r, F.lane); continue; } r -= I_FOLD;
                if (r < I_WIN) { p0_transpose_item(even_w_in, EVEN_IN, 0, 2304, D, WinT, 0, scr, r, F.lane); continue; } r -= I_WIN;
                if (r < I_WOUT) { p0_transpose_item(even_w_out, D, 0, D, D, (bf16_t*)(ws + FW_WOUT), 0, scr, r, F.lane); continue; } r -= I_WOUT;
                if (r < I_WQ) { p0_transpose_item(peer_wq, PEER_QW, 0, PEER_QW, D, (bf16_t*)(ws + FW_WQ), 0, scr, r, F.lane); continue; } r -= I_WQ;
                if (r < I_WQ) { p0_transpose_item(peer_wq + (size_t)D * PEER_QW, PEER_QW, 0, PEER_QW, D, (bf16_t*)(ws + FW_WQ) + (size_t)PEER_QW * D, 0, scr, r, F.lane); continue; } r -= I_WQ;
                if (r < I_OWIN) { p0_transpose_item(odd_w_in, ODD_IN, 0, ODD_IN, D, (bf16_t*)(ws + FW_OWIN), 0, scr, r, F.lane); continue; } r -= I_OWIN;
                p0_transpose_item(odd_w_out, D, 0, D, D, (bf16_t*)(ws + FW_OWOUT), 0, scr, r, F.lane);
            }
        }
        for (int r = F.gw; r < 512 + 128 + 65536; r += F.NGW) {
            if (r < 512) cvt_row(peer_keys + (size_t)r * D, (bf16_t*)(ws + FW_KEYS) + (size_t)r * D, F.lane);
            else if (r < 640) cvt_row(sgu_w + (size_t)(r - 512) * D, (bf16_t*)(ws + FW_SGUW) + (size_t)(r - 512) * D, F.lane);
            else { const int q = r - 640, l = q >> 15, uv = (q >> 14) & 1, e = q & 16383;
                const float* src = (uv ? peer_v : peer_u) + ((size_t)l * 16384 + e) * D;
                cvt_row(src, (bf16_t*)(ws + FW_TAB) + (size_t)q * D, F.lane); }
        }
    }
    SEAM(0);
    if (IN(1)) { Frame F = F0; asm volatile("" : "+v"(F.tid), "+v"(F.lane));
        for (int r = F.gw; r < NTOK + NCTX; r += F.NGW) {
            if (r < NTOK) { const float* m = MOD + (size_t)(r >> 12) * 6 * D; normmod_row(x + (size_t)r * D, norm1_g, m, m + D, H + (size_t)r * D, F.lane); }
            else { const int q = r - NTOK; const float* m = MOD + (size_t)4 * 6 * D; normmod_row(ctx + (size_t)q * D, norm1_g, m, m + D, HC + (size_t)q * D, F.lane); }
        }
    }
    SEAM(1);
    if (IN(2)) { Frame F = F0; asm volatile("" : "+v"(F.tid), "+v"(F.lane));
        {
            const f32x2* rt = (const f32x2*)(ws + FW_ROPE); LAS f32x2* dst = (LAS f32x2*)(F.lds + AUX_OFF);
            for (int i = F.tid; i < 1024; i += NWAVES * 64) dst[i] = rt[i];
            __syncthreads();
        }
        InProjOrder S{F.G, (int)blockIdx.x, (const char*)H, (const char*)HC, (const char*)WinT};
        InProjEpi E{(bf16_t*)(ws + FW_QB), (bf16_t*)(ws + FW_KB), (bf16_t*)(ws + FW_VT), (bf16_t*)(ws + FW_FTP), F.ctl + CW_KM2, (const LAS f32x2*)(F.lds + AUX_OFF)};
        pg8::gemm_phase<InProjEpi, InProjOrder>(F.lds, D, S, E);
    }
    SEAM(2);
    if (IN(3)) { Frame F = F0; asm volatile("" : "+v"(F.tid), "+v"(F.lane));
        attn_phase(F, (const bf16_t*)(ws + FW_QB), (const bf16_t*)(ws + FW_KB), (const bf16_t*)(ws + FW_VT), F.ctl + CW_KM2, (const float*)(ws + FW_LAM), args.in[12], (bf16_t*)(ws + FW_MIX));
        if (blockIdx.x < 128)
            fourier_unit(F, (int)blockIdx.x, (const bf16_t*)(ws + FW_FTP), (const bf16_t*)(ws + FW_MA), (const bf16_t*)(ws + FW_MB), (const f32x2*)(ws + FW_TW), (bf16_t*)(ws + FW_MIX));
    }
    SEAM(3);
    if (IN(4)) { Frame F = F0; asm volatile("" : "+v"(F.tid), "+v"(F.lane));
        StdOrder S{F.G, (int)blockIdx.x, 4, 256, (const char*)(ws + FW_MIX), (const char*)(ws + FW_WOUT)};
        EpiResid E{x, args.out, MOD + 2 * D};
        pg8::gemm_phase<EpiResid, StdOrder>(F.lds, D, S, E);
    }
    SEAM(4);
    if (IN(5)) { Frame F = F0; asm volatile("" : "+v"(F.tid), "+v"(F.lane));
        for (int r = F.gw; r < NTOK; r += F.NGW) { const float* mm = MOD + (size_t)(r >> 12) * 6 * D; normmod_row(args.out + (size_t)r * D, args.in[7], mm + 3 * D, mm + 4 * D, H + (size_t)r * D, F.lane); }
    }
    SEAM(5);
    if (IN(6)) { Frame F = F0; asm volatile("" : "+v"(F.tid), "+v"(F.lane));
        StdOrder S{F.G, (int)blockIdx.x, 8, 512, (const char*)H, (const char*)(ws + FW_WQ)};
        EpiStoreBf16 E{(bf16_t*)(ws + FW_PQ), PEER_QW};
        pg8::gemm_phase<EpiStoreBf16, StdOrder>(F.lds, D, S, E);
    }
    SEAM(6);
    if (IN(7)) { Frame F = F0; asm volatile("" : "+v"(F.tid), "+v"(F.lane)); topk_phase(F, (const bf16_t*)(ws + FW_PQ), (const bf16_t*)(ws + FW_KEYS), (int*)(ws + FW_IDX), (float*)(ws + FW_GATE)); }
    SEAM(7);
    if (IN(8)) { Frame F = F0; asm volatile("" : "+v"(F.tid), "+v"(F.lane)); peer_apply_phase<1>(F, H, (const int*)(ws + FW_IDX), (const float*)(ws + FW_GATE), (const bf16_t*)(ws + FW_TAB), (const bf16_t*)(ws + FW_TAB) + (size_t)16384 * D,
                                   MOD + 5 * D, args.out, norm1_g + D, MOD + 5 * 6 * D, H); }
    SEAM(8);
    if (IN(10)) { Frame F = F0; asm volatile("" : "+v"(F.tid), "+v"(F.lane));
        OddInOrder S{F.G, (int)blockIdx.x, (const char*)H, (const char*)(ws + FW_OWIN)};
        EpiOddIn E{(bf16_t*)(ws + FW_ZU), (bf16_t*)(ws + FW_ZVT), args.in[14], (float*)(F.ctl + CW_RSQ)};
        pg8::gemm_phase<EpiOddIn, OddInOrder>(F.lds, D, S, E);
    }
    SEAM(10);
    if (IN(11)) { Frame F = F0; asm volatile("" : "+v"(F.tid), "+v"(F.lane)); sgu_phase(F, (const bf16_t*)(ws + FW_ZU), (const bf16_t*)(ws + FW_ZVT), (const bf16_t*)(ws + FW_SGUW), (const float*)(F.ctl + CW_RSQ), args.in[15], args.in[17], (bf16_t*)(ws + FW_MIX)); }
    SEAM(11);
    if (IN(12)) { Frame F = F0; asm volatile("" : "+v"(F.tid), "+v"(F.lane));
        StdOrder S{F.G, (int)blockIdx.x, 4, 256, (const char*)(ws + FW_MIX), (const char*)(ws + FW_OWOUT)};
        EpiResid E{args.out, args.out, MOD + 5 * 6 * D + 2 * D};
        pg8::gemm_phase<EpiResid, StdOrder>(F.lds, D, S, E);
    }
    SEAM(12);
    if (IN(13)) { Frame F = F0; asm volatile("" : "+v"(F.tid), "+v"(F.lane));
        for (int r = F.gw; r < NTOK; r += F.NGW) { const float* mm = MOD + 5 * 6 * D + (size_t)(r >> 12) * 6 * D; normmod_row(args.out + (size_t)r * D, args.in[7] + D, mm + 3 * D, mm + 4 * D, H + (size_t)r * D, F.lane); }
    }
    SEAM(13);
    if (IN(14)) { Frame F = F0; asm volatile("" : "+v"(F.tid), "+v"(F.lane));
        StdOrder S{F.G, (int)blockIdx.x, 8, 512, (const char*)H, (const char*)(ws + FW_WQ) + (size_t)PEER_QW * D * 2};
        EpiStoreBf16 E{(bf16_t*)(ws + FW_PQ), PEER_QW};
        pg8::gemm_phase<EpiStoreBf16, StdOrder>(F.lds, D, S, E);
    }
    SEAM(14);
    if (IN(15)) { Frame F = F0; asm volatile("" : "+v"(F.tid), "+v"(F.lane)); topk_phase(F, (const bf16_t*)(ws + FW_PQ), (const bf16_t*)(ws + FW_KEYS) + (size_t)8 * 2 * 128 * 128, (int*)(ws + FW_IDX), (float*)(ws + FW_GATE)); }
    SEAM(15);
    if (IN(16)) { Frame F = F0; asm volatile("" : "+v"(F.tid), "+v"(F.lane)); peer_apply_phase<2>(F, H, (const int*)(ws + FW_IDX), (const float*)(ws + FW_GATE), (const bf16_t*)(ws + FW_TAB) + (size_t)2 * 16384 * D, (const bf16_t*)(ws + FW_TAB) + (size_t)3 * 16384 * D,
                                    MOD + 5 * 6 * D + 5 * D, args.out, args.in[8], nullptr, nullptr); }
#undef IN
#undef SEAM
}

__global__ void __launch_bounds__(256) k_adapt_p2(const bf16_t* QB, const bf16_t* KB, const bf16_t* VT, const bf16_t* FTP, bf16_t* qkvf, bf16_t* kvc, bf16_t* fcs) {
    const size_t gid = (size_t)blockIdx.x * 256 + threadIdx.x;
    if (gid < (size_t)NTOK * 2304) {
        const int tok = gid / 2304, cidx = gid % 2304, b = tok >> 12, tt = tok & (L - 1);
        bf16_t v;
        if (cidx < 768) v = (bf16_t)f2bf(bf2f(QB[(size_t)tok * 768 + cidx]) * (1.0f / C2));
        else if (cidx < 1536) v = KB[((size_t)b * KVLEN + CTX + tt) * 768 + cidx - 768];
        else v = VT[((size_t)b * 768 + cidx - 1536) * KVLEN + CTX + tt];
        qkvf[(size_t)tok * EVEN_IN + cidx] = v;
        return;
    }
    size_t g2 = gid - (size_t)NTOK * 2304;
    if (g2 < (size_t)NCTX * 1536) {
        const int ct = g2 / 1536, cidx = g2 % 1536, b = ct >> 8, j = ct & 255;
        kvc[g2] = cidx < 768 ? KB[((size_t)b * KVLEN + j) * 768 + cidx] : VT[((size_t)b * 768 + cidx - 768) * KVLEN + j];
        return;
    }
    g2 -= (size_t)NCTX * 1536;
    if (g2 < (size_t)NTOK * 512) {
        const int tok = g2 / 512, cidx = g2 % 512, b = tok >> 12, n = tok & (L - 1), ri = cidx >> 8, cg = (cidx >> 3) & 31, col = cidx & 7, n1 = n >> 6, n2 = n & 63;
        fcs[g2] = FTP[(((size_t)(b * 32 + cg) * 512) + n2 * 8 + col) * 128 + ri * 64 + n1];
    }
}
extern "C" void kernel_launch(void* const* d_in, const int* in_sizes, int n_in, void* d_out, int out_size, void* d_ws, size_t ws_size, hipStream_t stream) {
    static int grid = 0;
    if (grid == 0) {
        if (n_in != 23 || ws_size < WS_NEED || out_size != NTOK * D) { fprintf(stderr, "kernel_launch: unexpected n_in %d / ws_size %zu / out_size %d\n", n_in, ws_size, out_size); grid = -1; return; }
        int dev = 0, cus = 0, per_cu = 0;
        if (hipGetDevice(&dev) != hipSuccess || hipDeviceGetAttribute(&cus, hipDeviceAttributeMultiprocessorCount, dev) != hipSuccess) { grid = -1; return; }
        if (hipFuncSetAttribute((const void*)mega_fwd, hipFuncAttributeMaxDynamicSharedMemorySize, LDS_BYTES) != hipSuccess) { fprintf(stderr, "kernel_launch: hipFuncSetAttribute failed\n"); grid = -1; return; }
        if (hipOccupancyMaxActiveBlocksPerMultiprocessor(&per_cu, (const void*)mega_fwd, NWAVES * 64, LDS_BYTES) != hipSuccess || per_cu < 1) { fprintf(stderr, "kernel_launch: occupancy query says %d blocks/CU\n", per_cu); (void)hipGetLastError(); grid = -1; return; }
        grid = cus;
        fprintf(stderr, "kernel_launch: grid %d (cus %d, per_cu %d), ws_size %zu\n", grid, cus, per_cu, ws_size);
    }
    if (grid < 0) return;
    const float* x = (const float*)d_in[0];
    const float* norm2_g = (const float*)d_in[7];
    const float* final_g = (const float*)d_in[8]; const float* even_w_out = (const float*)d_in[10];
    const float* diff_norm_g = (const float*)d_in[12]; const float* odd_w_in = (const float*)d_in[13];
    const float* odd_b_in = (const float*)d_in[14]; const float* sgu_norm_g = (const float*)d_in[15]; const float* sgu_w = (const float*)d_in[16]; const float* sgu_b = (const float*)d_in[17];
    const float* odd_w_out = (const float*)d_in[18]; const float* peer_wq = (const float*)d_in[19]; const float* peer_keys = (const float*)d_in[20];
    const float* peer_u = (const float*)d_in[21]; const float* peer_v = (const float*)d_in[22]; const float* norm1_g = (const float*)d_in[6];
    char* ws = (char*)d_ws; float* out = (float*)d_out;
    (void)hipMemsetAsync(ws + FW_CTL, 0, CTL_ZERO_BYTES, stream);
    MArgs a{};
    for (int i = 0; i < 23; ++i) a.in[i] = (const float*)d_in[i];
    a.out = out; a.ws = (unsigned char*)d_ws;
    void* kargs[] = {&a};
    a.ph_lo = 0; a.ph_hi = 17;
    hipError_t le = hipLaunchCooperativeKernel((const void*)mega_fwd, dim3(grid), dim3(NWAVES * 64), kargs, LDS_BYTES, stream);
    if (le != hipSuccess) { fprintf(stderr, "kernel_launch: cooperative launch failed: %s\n", hipGetErrorString(le)); return; }
}
```
